# Optimizing an MI355X kernel written in HIP

```python
import jax, jax.numpy as jnp
from jax import lax
import numpy as np

D_MODEL = 1024
BATCH = 8
SEQ = 2048
DEPTH = 2

CONV_WIDTH = 3
CONV_CHANNELS = D_MODEL // 2
HGRN_HEAD_DIM = 128
HGRN_HEADS = (D_MODEL // 2) // HGRN_HEAD_DIM
HGRN_WIDTH = HGRN_HEADS * HGRN_HEAD_DIM
HGRN_CHUNK = 64
ATTN_HEAD_DIM = 64
ATTN_HEADS = D_MODEL // ATTN_HEAD_DIM
DILATED_BRANCHES = ((128, 1), (512, 4), (2048, 16))
ATTN_BLOCK = 128
ROPE_THETA = 10000.0
D_FF = -(-8 * D_MODEL // (3 * 256)) * 256
RMS_EPS = 1e-6
N_EVEN = (DEPTH + 1) // 2
N_ODD = DEPTH // 2
REC_IN_WIDTH = 3 * CONV_CHANNELS + 4 * HGRN_WIDTH

kernel_name = "hybrid_conv_hgrn2_dilated_attn_block"


def rmsnorm(x, g):
    xf = x.astype(jnp.float32)
    y = xf * lax.rsqrt(jnp.mean(xf * xf, axis=-1, keepdims=True) + RMS_EPS)
    return (y * g.astype(jnp.float32)).astype(x.dtype)


def short_conv_mixer(b_gate, c_gate, v, conv_w):
    u = c_gate * v
    S = u.shape[1]
    up = jnp.pad(u, ((0, 0), (CONV_WIDTH - 1, 0), (0, 0)))
    y = conv_w[0] * up[:, 0:S]
    for j in range(1, CONV_WIDTH):
        y = y + conv_w[j] * up[:, j:j + S]
    return b_gate * y


def hgrn2_mixer(q, f_logit, i_in, g, lb, norm_g):
    B, S, _ = q.shape
    H, Dh, C = HGRN_HEADS, HGRN_HEAD_DIM, HGRN_CHUNK
    nc = S // C

    def heads(t):
        return t.reshape(B, S, H, Dh).transpose(0, 2, 1, 3).astype(jnp.float32)

    z = heads(f_logit)
    lbh = lb.reshape(H, 1, Dh)
    log_f = jnp.logaddexp(jnp.log(lbh), jnp.log1p(-lbh) + jax.nn.log_sigmoid(z))
    k = (1.0 - lbh) * jax.nn.sigmoid(-z)
    qh = heads(q)
    vh = heads(jax.nn.silu(i_in))

    def chunks(t):
        return t.reshape(B, H, nc, C, Dh).transpose(2, 0, 1, 3, 4)

    causal = jnp.tril(jnp.ones((C, C), dtype=bool))

    def step(state, inp):
        qc, kc, vc, lfc = inp
        G = jnp.cumsum(lfc, axis=2)
        o_inter = jnp.einsum('bhtk,bhkv->bhtv', qc * jnp.exp(G), state)
        rel = G[:, :, :, None, :] - G[:, :, None, :, :]
        decay = jnp.exp(jnp.where(causal[:, :, None], rel, -jnp.inf))
        scores = jnp.einsum('bhtk,bhtsk,bhsk->bhts', qc, decay, kc)
        o = o_inter + jnp.einsum('bhts,bhsv->bhtv', scores, vc)
        G_last = G[:, :, -1:, :]
        new_state = (jnp.exp(G_last[:, :, 0, :])[..., None] * state
                     + jnp.einsum('bhsk,bhsv->bhkv', kc * jnp.exp(G_last - G), vc))
        return new_state, o

    state0 = jnp.zeros((B, H, Dh, Dh), jnp.float32)
    _, o = lax.scan(step, state0, (chunks(qh), chunks(k), chunks(vh), chunks(log_f)))
    o = o.transpose(1, 2, 0, 3, 4).reshape(B, H, S, Dh)
    o = rmsnorm(o, norm_g)
    o = o.transpose(0, 2, 1, 3).reshape(B, S, HGRN_WIDTH)
    return (o * jax.nn.silu(g.astype(jnp.float32))).astype(q.dtype)


def rope(t, positions):
    hd = t.shape[-1]
    half = hd // 2
    freqs = ROPE_THETA ** (-jnp.arange(half, dtype=jnp.float32) / half)
    ang = positions.astype(jnp.float32)[:, None] * freqs[None, :]
    cos, sin = jnp.cos(ang), jnp.sin(ang)
    tf = t.astype(jnp.float32)
    t1, t2 = tf[..., :half], tf[..., half:]
    return jnp.concatenate([t1 * cos - t2 * sin, t1 * sin + t2 * cos], axis=-1)


def dilated_branch(q, k, v, dilation, span):
    B, H, S, hd = q.shape
    L = S // dilation
    nb = -(-L // ATTN_BLOCK)
    Lp = nb * ATTN_BLOCK

    def strided(t):
        t = t.reshape(B, H, L, dilation, hd).transpose(0, 1, 3, 2, 4)
        t = jnp.pad(t, ((0, 0), (0, 0), (0, 0), (0, Lp - L), (0, 0)))
        return t.reshape(B, H, dilation, nb, ATTN_BLOCK, hd)

    def with_prev(t):
        prev = jnp.pad(t, ((0, 0), (0, 0), (0, 0), (1, 0), (0, 0), (0, 0)))[:, :, :, :-1]
        return jnp.concatenate([prev, t], axis=4)

    qb = strided(q)
    kk = with_prev(strided(k))
    vv = with_prev(strided(v))
    s = jnp.einsum('bhrnqd,bhrnkd->bhrnqk', qb, kk).astype(jnp.float32)
    qi = jnp.arange(ATTN_BLOCK)[:, None]
    kj = jnp.arange(2 * ATTN_BLOCK)[None, :]
    rel = ATTN_BLOCK + qi - kj
    band = (rel >= 0) & (rel <= span)
    has_prev = (jnp.arange(nb)[:, None, None] > 0) | (kj >= ATTN_BLOCK)[None]
    mask = band[None] & has_prev
    s = jnp.where(mask, s, -jnp.inf)
    m = jnp.max(s, axis=-1, keepdims=True)
    p = jnp.exp(s - m)
    denom = jnp.sum(p, axis=-1, keepdims=True)
    o = jnp.einsum('bhrnqk,bhrnkd->bhrnqd', (p / denom).astype(vv.dtype), vv)
    lse = (m + jnp.log(denom))[..., 0]
    o = o.reshape(B, H, dilation, Lp, hd)[:, :, :, :L].transpose(0, 1, 3, 2, 4).reshape(B, H, S, hd)
    lse = lse.reshape(B, H, dilation, Lp)[..., :L].transpose(0, 1, 3, 2).reshape(B, H, S)
    return o, lse


def dilated_attention(q, k, v):
    outs, lses = [], []
    for window, dilation in DILATED_BRANCHES:
        o, lse = dilated_branch(q, k, v, dilation, window // dilation)
        outs.append(o.astype(jnp.float32))
        lses.append(lse)
    w = jax.nn.softmax(jnp.stack(lses, axis=0), axis=0)
    return jnp.einsum('nbhs,nbhsd->bhsd', w, jnp.stack(outs, axis=0))


def swiglu(h, w_in, w_out):
    gate, up = jnp.split(h @ w_in, 2, axis=-1)
    return (jax.nn.silu(gate) * up) @ w_out


def setup_inputs(seed: int = 0) -> dict:
    key = jax.random.key(seed)
    ks = jax.random.split(key, 13)
    D = D_MODEL
    f32 = jnp.float32

    def nrm(k, shape, scale):
        return jax.random.normal(k, shape, f32) * scale

    return {
        "x": nrm(ks[0], (BATCH, SEQ, D), 1.0),
        "mix_norm": 1.0 + nrm(ks[1], (DEPTH, D), 0.02),
        "ffn_norm": 1.0 + nrm(ks[2], (DEPTH, D), 0.02),
        "w_in_rec": nrm(ks[3], (N_EVEN, D, REC_IN_WIDTH), D ** -0.5),
        "conv_w": nrm(ks[4], (N_EVEN, CONV_WIDTH, CONV_CHANNELS), CONV_WIDTH ** -0.5),
        "hgrn_lb": nrm(ks[5], (DEPTH + 1, HGRN_WIDTH), 0.5),
        "hgrn_norm": 1.0 + nrm(ks[6], (N_EVEN, HGRN_HEAD_DIM), 0.02),
        "w_out_rec": nrm(ks[7], (N_EVEN, CONV_CHANNELS + HGRN_WIDTH, D), (CONV_CHANNELS + HGRN_WIDTH) ** -0.5),
        "w_qkv_attn": nrm(ks[8], (N_ODD, D, 3 * ATTN_HEADS * ATTN_HEAD_DIM), D ** -0.5),
        "w_o_attn": nrm(ks[9], (N_ODD, ATTN_HEADS * ATTN_HEAD_DIM, D), (ATTN_HEADS * ATTN_HEAD_DIM) ** -0.5),
        "w_ffn_in": nrm(ks[10], (DEPTH, D, 2 * D_FF), D ** -0.5),
        "w_ffn_out": nrm(ks[11], (DEPTH, D_FF, D), D_FF ** -0.5),
        "final_norm": 1.0 + nrm(ks[12], (D,), 0.02),
    }


def reference(x, mix_norm, ffn_norm, w_in_rec, conv_w, hgrn_lb, hgrn_norm, w_out_rec,
              w_qkv_attn, w_o_attn, w_ffn_in, w_ffn_out, final_norm):
    B, S, D = x.shape
    positions = jnp.arange(S, dtype=jnp.int32)
    lb_cum = jnp.cumsum(jax.nn.softmax(hgrn_lb.astype(jnp.float32), axis=0), axis=0)
    splits = [CONV_CHANNELS, 2 * CONV_CHANNELS, 3 * CONV_CHANNELS,
              3 * CONV_CHANNELS + HGRN_WIDTH, 3 * CONV_CHANNELS + 2 * HGRN_WIDTH,
              3 * CONV_CHANNELS + 3 * HGRN_WIDTH]
    for layer in range(DEPTH):
        h = rmsnorm(x, mix_norm[layer])
        if layer % 2 == 0:
            e = layer // 2
            proj = h @ w_in_rec[e]
            b_g, c_g, v_c, q_r, f_r, i_r, g_r = jnp.split(proj, splits, axis=-1)
            a_out = short_conv_mixer(b_g, c_g, v_c, conv_w[e])
            lb = lb_cum[layer + 1] - lb_cum[0]
            b_out = hgrn2_mixer(q_r, f_r, i_r, g_r, lb, hgrn_norm[e])
            mix = jnp.concatenate([a_out.astype(x.dtype), b_out.astype(x.dtype)], axis=-1) @ w_out_rec[e]
        else:
            o_idx = layer // 2
            qkv = (h @ w_qkv_attn[o_idx]).reshape(B, S, 3, ATTN_HEADS, ATTN_HEAD_DIM)
            qkv = qkv.transpose(2, 0, 3, 1, 4)
            q = rope(qkv[0], positions) * (ATTN_HEAD_DIM ** -0.5)
            k = rope(qkv[1], positions)
            v = qkv[2]
            o = dilated_attention(q, k, v)
            o = o.transpose(0, 2, 1, 3).reshape(B, S, ATTN_HEADS * ATTN_HEAD_DIM).astype(x.dtype)
            mix = o @ w_o_attn[o_idx]
        x = x + mix.astype(x.dtype)
        h = rmsnorm(x, ffn_norm[layer])
        x = x + swiglu(h, w_ffn_in[layer], w_ffn_out[layer]).astype(x.dtype)
    return rmsnorm(x, final_norm)
```

```cpp
#include <hip/hip_runtime.h>
#include <hip/hip_cooperative_groups.h>
#include <cstdio>
#include <cstdint>
namespace cg = cooperative_groups;
#ifndef MK_SPLIT
#define MK_SPLIT 0
#endif
namespace pg8 {
#define PG8_LAS __attribute__((address_space(3)))
typedef unsigned short bf16_t;
typedef short bf16x8 __attribute__((ext_vector_type(8)));
typedef float f32x4 __attribute__((ext_vector_type(4)));
typedef unsigned u32x4 __attribute__((ext_vector_type(4)));
constexpr int BM = 256, BK = 64, HALF = 128, HTB = HALF * BK * 2  , STAGE_BYTES = 8 * HTB, NXCD = 8, WGM = 8;

__host__ __device__ __forceinline__ int lds_byte(int r, int c) { const int st = (r >> 4) * 2 + (c >> 5), rr = r & 15, cc = c & 31, ob = rr * 64 + cc * 2; return st * 1024 + (ob ^ (((ob >> 9) & 1) << 5)); }
__host__ __device__ __forceinline__ void stage_rc(int b, int& R, int& C) { const int st = b / 1024, sb = b % 1024, swz = sb ^ (((sb >> 9) & 1) << 5); R = (st >> 1) * 16 + swz / 64; C = (st & 1) * 32 + (swz % 64) / 2; }
__host__ __device__ __forceinline__ int perm32(int rho) { const int n = rho >> 4, i = rho & 15; return 8 * (i >> 2) + 4 * n + (i & 3); }

struct Unit { int pm, pn; };
struct Gemm { const bf16_t* A; const bf16_t* Bt; int M, N, K; };

struct StaticOrder {
    int nM, nN, nwg, G, c;
    __host__ __device__ void init(int M, int N, int G_, int c_) { nM = M / BM; nN = N / BM; nwg = nM * nN; G = G_; c = c_; }
    __host__ __device__ bool next(int i, Unit& u) const {
        const long L = (long)i * G + c; if (L >= nwg) return false;
        int wgid = (int)L; { const int q = nwg / NXCD, r = nwg % NXCD, xcd = wgid % NXCD, off = wgid / NXCD; wgid = (xcd < r ? xcd * (q + 1) : r * (q + 1) + (xcd - r) * q) + off; }
        const int nig = WGM * nN, gid = wgid / nig, fm = gid * WGM, gsz = (nM - fm) < WGM ? (nM - fm) : WGM;
        u.pm = fm + ((wgid % nig) % gsz); u.pn = (wgid % nig) / gsz; return true;
    }
    __device__ __forceinline__ void a_ready(const Unit&) const {}
    __device__ __forceinline__ void done(const Unit&) const {}
};
typedef float cvt_f32x2_t __attribute__((ext_vector_type(2))); typedef __bf16 cvt_bf16x2_t __attribute__((ext_vector_type(2)));
__device__ __forceinline__ unsigned cvt_pk_bf16(float lo, float hi) { cvt_f32x2_t v = {lo, hi}; cvt_bf16x2_t b = __builtin_convertvector(v, cvt_bf16x2_t); return __builtin_bit_cast(unsigned, b); }
typedef float f32x2 __attribute__((ext_vector_type(2)));

template <class Epi, class Sched, bool ALIGN_EPI = false, bool SP2 = false>
__device__ __forceinline__ void gemm_phase(PG8_LAS unsigned char* lds, const Gemm g, const Sched& S, const Epi& E) {
    const int tid = threadIdx.x, wid = __builtin_amdgcn_readfirstlane(tid >> 6), lane = tid & 63, wr = wid >> 2, wc = wid & 3, fr = lane & 15, fq = lane >> 4;
    const int K = g.K, nt = K / BK;
    unsigned voffA[2], voffB[2];
#pragma unroll
    for (int i = 0; i < 2; ++i) { int R, C; stage_rc(tid * 16 + i * 8192, R, C); const int Rb = Epi::PERM ? ((R & ~31) + perm32(R & 31)) : R;
        voffA[i] = (unsigned)(R * K + C) * 2u; voffB[i] = (unsigned)(Rb * K + C) * 2u; }
    const size_t kstep = (size_t)(BK * 2);
    const size_t hstep = (size_t)HALF * K * 2;
    const size_t tstep = 2 * hstep;
    const unsigned ldsw = (unsigned)wid * 1024u;
    const int aoff = lds_byte(wr * 64 + fr, fq * 8), boff = lds_byte(wc * 32 + fr, fq * 8);
#define PG8_SA(b, h) (((b) * 2 + (h)) * HTB)
#define PG8_SB(b, h) ((4 + (b) * 2 + (h)) * HTB)
#define PG8_STAGE(bufoff, gbase, voff) do { _Pragma("unroll") for (int _i = 0; _i < 2; ++_i) \
        __builtin_amdgcn_global_load_lds((const unsigned*)((const char*)(gbase) + (voff)[_i]), (PG8_LAS unsigned*)(lds + (bufoff) + ldsw + _i * 8192), 16, 0, 0); } while (0)
#define PG8_LDA(dst, b, h) do { _Pragma("unroll") for (int m = 0; m < 4; ++m) _Pragma("unroll") for (int k = 0; k < 2; ++k) dst[m][k] = *(const PG8_LAS bf16x8*)(lds + PG8_SA(b, h) + aoff + m * 2048 + k * 1024); } while (0)
#define PG8_LDB(dst, b, h) do { _Pragma("unroll") for (int n = 0; n < 2; ++n) _Pragma("unroll") for (int k = 0; k < 2; ++k) dst[n][k] = *(const PG8_LAS bf16x8*)(lds + PG8_SB(b, h) + boff + n * 2048 + k * 1024); } while (0)
#define PG8_MMA(ai, bj, At, Bt) do { __builtin_amdgcn_s_setprio(1); _Pragma("unroll") for (int m = 0; m < 4; ++m) _Pragma("unroll") for (int n = 0; n < 2; ++n) _Pragma("unroll") for (int k = 0; k < 2; ++k) \
        acc[ai][bj][m][n] = __builtin_amdgcn_mfma_f32_16x16x32_bf16(Bt[n][k], At[m][k], acc[ai][bj][m][n], 0, 0, 0); __builtin_amdgcn_s_setprio(0); } while (0)
#define PG8_WAIT_V(n) asm volatile("s_waitcnt vmcnt(" #n ")" ::: "memory")
#define PG8_WAIT_L(n) asm volatile("s_waitcnt lgkmcnt(" #n ")" ::: "memory")
#define PG8_BAR __builtin_amdgcn_s_barrier()
#define PG8_SCHED __builtin_amdgcn_sched_barrier(0)
    Unit cur, nxt; int ui = 0;
    if (!S.next(0, cur)) return;
    f32x4 acc[2][2][4][2];
#pragma unroll
    for (int a = 0; a < 2; ++a)
#pragma unroll
        for (int b = 0; b < 2; ++b)
#pragma unroll
            for (int m = 0; m < 4; ++m)
#pragma unroll
                for (int n = 0; n < 2; ++n) acc[a][b][m][n] = (f32x4){0.f, 0.f, 0.f, 0.f};
    bf16x8 At[4][2], B0[2][2], B1[2][2];
    const char* cA = (const char*)g.A + (size_t)cur.pm * tstep; const char* cB = (const char*)g.Bt + (size_t)cur.pn * tstep;
    S.a_ready(cur);
    typename Epi::Pre pre; E.prefetch(pre, cur, wr, fr); __builtin_amdgcn_sched_barrier(0);
    if constexpr (SP2) {
        PG8_STAGE(PG8_SB(0, 0), cB, voffB); PG8_STAGE(PG8_SB(0, 1), cB + hstep, voffB); PG8_STAGE(PG8_SA(0, 0), cA, voffA); PG8_STAGE(PG8_SA(0, 1), cA + hstep, voffA);
        if (wr == 1) PG8_BAR;
        PG8_WAIT_V(2); PG8_BAR;
        PG8_STAGE(PG8_SB(1, 0), cB + kstep, voffB); PG8_STAGE(PG8_SA(1, 0), cA + kstep, voffA); PG8_STAGE(PG8_SB(1, 1), cB + hstep + kstep, voffB);
        PG8_WAIT_V(6); PG8_BAR;
    } else {
        PG8_STAGE(PG8_SB(0, 0), cB, voffB); PG8_STAGE(PG8_SA(0, 0), cA, voffA); PG8_STAGE(PG8_SB(0, 1), cB + hstep, voffB); PG8_STAGE(PG8_SA(0, 1), cA + hstep, voffA);
        if (wr == 1) PG8_BAR;
        PG8_WAIT_V(4); PG8_BAR;
        PG8_STAGE(PG8_SB(1, 0), cB + kstep, voffB); PG8_STAGE(PG8_SA(1, 0), cA + kstep, voffA); PG8_STAGE(PG8_SB(1, 1), cB + hstep + kstep, voffB);
        PG8_WAIT_V(6); PG8_BAR;
    }
    for (;;) {
        const bool has_next = S.next(ui + 1, nxt);
        const char* nA = has_next ? (const char*)g.A + (size_t)nxt.pm * tstep : cA; const char* nB = has_next ? (const char*)g.Bt + (size_t)nxt.pn * tstep : cB;
        for (int t = 0; t < nt; t += 2) {
            const bool last = (t == nt - 2);
            const char* a1 = cA + (size_t)(t + 1) * kstep;
            const char* a2 = last ? nA : cA + (size_t)(t + 2) * kstep; const char* b2 = last ? nB : cB + (size_t)(t + 2) * kstep;
            const char* a3 = a2 + kstep; const char* b3 = b2 + kstep;
            if (last && has_next) S.a_ready(nxt);
            if constexpr (SP2) {
            PG8_LDB(B0, 0, 0); PG8_LDB(B1, 0, 1); PG8_SCHED; PG8_LDA(At, 0, 0); PG8_STAGE(PG8_SA(1, 1), a1 + hstep, voffA);
            PG8_WAIT_V(8); PG8_WAIT_L(0); PG8_BAR; PG8_MMA(0, 0, At, B0); PG8_MMA(0, 1, At, B1); PG8_BAR; PG8_SCHED;
            PG8_LDA(At, 0, 1); PG8_STAGE(PG8_SB(0, 0), b2, voffB); PG8_STAGE(PG8_SB(0, 1), b2 + hstep, voffB); PG8_STAGE(PG8_SA(0, 0), a2, voffA);
            PG8_WAIT_V(8); PG8_WAIT_L(0); PG8_BAR; PG8_MMA(1, 0, At, B0); PG8_MMA(1, 1, At, B1); PG8_BAR; PG8_SCHED;
            PG8_LDB(B0, 1, 0); PG8_LDB(B1, 1, 1); PG8_SCHED; PG8_LDA(At, 1, 0); PG8_STAGE(PG8_SA(0, 1), a2 + hstep, voffA);
            PG8_WAIT_V(8); PG8_WAIT_L(0); PG8_BAR; PG8_MMA(0, 0, At, B0); PG8_MMA(0, 1, At, B1); PG8_BAR; PG8_SCHED;
            PG8_LDA(At, 1, 1); PG8_STAGE(PG8_SB(1, 0), b3, voffB); PG8_STAGE(PG8_SB(1, 1), b3 + hstep, voffB); PG8_STAGE(PG8_SA(1, 0), a3, voffA);
            PG8_WAIT_V(8); PG8_WAIT_L(0); PG8_BAR; PG8_MMA(1, 0, At, B0); PG8_MMA(1, 1, At, B1); PG8_BAR; PG8_SCHED;
            } else {
            PG8_LDB(B0, 0, 0); PG8_SCHED; PG8_LDA(At, 0, 0); PG8_STAGE(PG8_SA(1, 1), a1 + hstep, voffA);
            PG8_WAIT_L(8); PG8_BAR; PG8_WAIT_L(0); PG8_MMA(0, 0, At, B0); PG8_BAR; PG8_SCHED;
            PG8_LDB(B1, 0, 1); PG8_STAGE(PG8_SB(0, 0), b2, voffB);
            PG8_BAR; PG8_WAIT_L(0); PG8_MMA(0, 1, At, B1); PG8_BAR;
            PG8_LDA(At, 0, 1); PG8_STAGE(PG8_SA(0, 0), a2, voffA);
            PG8_BAR; PG8_WAIT_L(0); PG8_MMA(1, 0, At, B0); PG8_BAR; PG8_SCHED;
            PG8_STAGE(PG8_SB(0, 1), b2 + hstep, voffB);
            PG8_WAIT_V(6); PG8_BAR; PG8_MMA(1, 1, At, B1); PG8_BAR;
            PG8_LDB(B0, 1, 0); PG8_SCHED; PG8_LDA(At, 1, 0); PG8_STAGE(PG8_SA(0, 1), a2 + hstep, voffA);
            PG8_WAIT_L(8); PG8_BAR; PG8_WAIT_L(0); PG8_MMA(0, 0, At, B0); PG8_BAR; PG8_SCHED;
            PG8_LDB(B1, 1, 1); PG8_STAGE(PG8_SB(1, 0), b3, voffB);
            PG8_BAR; PG8_WAIT_L(0); PG8_MMA(0, 1, At, B1); PG8_BAR;
            PG8_LDA(At, 1, 1); PG8_STAGE(PG8_SA(1, 0), a3, voffA);
            PG8_BAR; PG8_WAIT_L(0); PG8_MMA(1, 0, At, B0); PG8_BAR; PG8_SCHED;
            PG8_STAGE(PG8_SB(1, 1), b3 + hstep, voffB);
            PG8_WAIT_V(6); PG8_BAR; PG8_MMA(1, 1, At, B1); PG8_BAR;
            }
        }
        if constexpr (ALIGN_EPI) { if (wr == 0) PG8_BAR; }
        if constexpr (!Epi::AFTER_DRAIN) { E(acc, cur, wr, wc, fr, fq, pre); S.done(cur); }
        if (!has_next) break;
#pragma unroll
        for (int a = 0; a < 2; ++a)
#pragma unroll
            for (int b = 0; b < 2; ++b)
#pragma unroll
                for (int m = 0; m < 4; ++m)
#pragma unroll
                    for (int n = 0; n < 2; ++n) acc[a][b][m][n] = (f32x4){0.f, 0.f, 0.f, 0.f};
        cur = nxt; cA = nA; cB = nB; ++ui;
        E.prefetch(pre, cur, wr, fr); __builtin_amdgcn_sched_barrier(0);
        if constexpr (ALIGN_EPI) { if (wr == 1) PG8_BAR; }
    }
    PG8_WAIT_V(0);
    if constexpr (!ALIGN_EPI) { if (wr == 0) PG8_BAR; }
    PG8_BAR;
    if constexpr (Epi::AFTER_DRAIN) { E.fused(acc, cur, wr, wc, fr, fq, lds, wid, lane); S.done(cur); }
#undef PG8_SA
#undef PG8_SB
#undef PG8_STAGE
#undef PG8_LDA
#undef PG8_LDB
#undef PG8_MMA
#undef PG8_WAIT_V
#undef PG8_WAIT_L
#undef PG8_BAR
#undef PG8_SCHED
}
}

constexpr int T_TOK = 16384, SEQ = 2048, DM = 1024, DFF = 2816, NPROJ = 3584;
constexpr float RMS_EPS = 1e-6f;
constexpr size_t MiB = 1u << 20;
constexpr size_t WS_SS = 0;
constexpr size_t WS_DEC = 512 * 1024;
constexpr size_t WS_ROPE = 1 * MiB;
constexpr size_t WS_W_INREC = 2 * MiB, WS_W_OUTREC = 9 * MiB, WS_W_QKV = 11 * MiB, WS_W_O = 17 * MiB;
constexpr size_t WS_W_FFNIN0 = 19 * MiB, WS_W_FFNIN1 = 30 * MiB, WS_W_FFNOUT0 = 41 * MiB, WS_W_FFNOUT1 = 46 * MiB + 512 * 1024;
constexpr size_t WS_XB = 52 * MiB;
constexpr size_t WS_MIX = 84 * MiB;
constexpr size_t WS_BIG = 116 * MiB;
constexpr size_t WS_OB2 = 212 * MiB;
constexpr size_t WS_LSE = 244 * MiB;
constexpr size_t WS_END = 247 * MiB;
constexpr int LDS_BYTES = 147456 + 256;
constexpr int LDS_MISC = 147456;
constexpr size_t WS_BAR = 384 * 1024;

typedef unsigned short bf16;
using pg8::bf16x8; using pg8::f32x4; using pg8::u32x4;
typedef float f32x16 __attribute__((ext_vector_type(16)));
typedef unsigned u32x2 __attribute__((ext_vector_type(2)));

struct Params {
    const float *x, *mix_norm, *ffn_norm, *w_in_rec, *conv_w, *hgrn_lb, *hgrn_norm, *w_out_rec, *w_qkv, *w_o, *w_ffn_in, *w_ffn_out, *final_norm;
    float* out; unsigned char* ws;
};

typedef float f32x2_t __attribute__((ext_vector_type(2)));
typedef __bf16 bf16x2_t __attribute__((ext_vector_type(2)));
__device__ __forceinline__ unsigned pk2(float lo, float hi) { f32x2_t v = {lo, hi}; bf16x2_t b = __builtin_convertvector(v, bf16x2_t); return __builtin_bit_cast(unsigned, b); }
__device__ __forceinline__ unsigned f2bf(float f) { return pk2(f, 0.f) & 0xffffu; }
__device__ __forceinline__ float bf2f(unsigned short b) { return __builtin_bit_cast(float, (unsigned)b << 16); }
__device__ __forceinline__ float bflo(unsigned u) { return __builtin_bit_cast(float, u << 16); }
__device__ __forceinline__ float bfhi(unsigned u) { return __builtin_bit_cast(float, u & 0xffff0000u); }
__device__ __forceinline__ float wave_sum(float v) {
#pragma unroll
    for (int o = 1; o < 64; o <<= 1) v += __shfl_xor(v, o);
    return v;
}
__device__ __forceinline__ float xor32_max(float x) { const unsigned xi = __builtin_bit_cast(unsigned, x); auto r = __builtin_amdgcn_permlane32_swap(xi, xi, false, false); return fmaxf(__builtin_bit_cast(float, (unsigned)r[0]), __builtin_bit_cast(float, (unsigned)r[1])); }
__device__ __forceinline__ float xor32_sum(float x) { const unsigned xi = __builtin_bit_cast(unsigned, x); auto r = __builtin_amdgcn_permlane32_swap(xi, xi, false, false); return __builtin_bit_cast(float, (unsigned)r[0]) + __builtin_bit_cast(float, (unsigned)r[1]); }
__device__ __forceinline__ float sigmoidf_(float z) { return __builtin_amdgcn_rcpf(1.f + __expf(-z)); }

namespace pg8 {
#ifndef MK_WT_STORES
#define MK_WT_STORES 1
#endif
__device__ __forceinline__ void st16(void* p, u32x4 v) {
#if MK_WT_STORES
    asm volatile("global_store_dwordx4 %0, %1, off sc1\n\ts_nop 1" :: "v"(p), "v"(v) : "memory");
#else
    *(u32x4*)p = v;
#endif
}
struct EpiScaleBf16 {
    static constexpr bool PERM = true, AFTER_DRAIN = false;
    bf16_t* O; int ldc; const float* ss;
    struct Pre { float ssv[2][4]; };
    __device__ __forceinline__ void prefetch(Pre& pre, const Unit& u, int wr, int fr) const {
#pragma unroll
        for (int ai = 0; ai < 2; ++ai)
#pragma unroll
            for (int m = 0; m < 4; ++m) pre.ssv[ai][m] = ss[u.pm * BM + wr * 64 + fr + ai * HALF + m * 16];
    }
    __device__ __forceinline__ void operator()(const f32x4 (&acc)[2][2][4][2], const Unit& u, int wr, int wc, int fr, int fq, const Pre& pre) const {
        const int row0 = u.pm * BM + wr * 64 + fr, col0 = u.pn * BM + wc * 32 + 8 * fq;
#pragma unroll
        for (int ai = 0; ai < 2; ++ai)
#pragma unroll
            for (int m = 0; m < 4; ++m) {
                const int row = row0 + ai * HALF + m * 16;
                const float r = rsqrtf(pre.ssv[ai][m] * (1.f / 1024.f) + 1e-6f);
                bf16_t* rowp = O + (size_t)row * ldc + col0;
#pragma unroll
                for (int bj = 0; bj < 2; ++bj) {
                    const f32x4 v0 = acc[ai][bj][m][0] * r, v1 = acc[ai][bj][m][1] * r;
                    u32x4 w; w.x = cvt_pk_bf16(v0[0], v0[1]); w.y = cvt_pk_bf16(v0[2], v0[3]); w.z = cvt_pk_bf16(v1[0], v1[1]); w.w = cvt_pk_bf16(v1[2], v1[3]);
                    st16(rowp + bj * HALF, w);
                }
            }
    }
};
struct EpiSwiGLU {
    static constexpr bool PERM = true, AFTER_DRAIN = false;
    bf16_t* H; const float* ss;
    struct Pre { float ssv[2][4]; };
    __device__ __forceinline__ void prefetch(Pre& pre, const Unit& u, int wr, int fr) const {
#pragma unroll
        for (int ai = 0; ai < 2; ++ai)
#pragma unroll
            for (int m = 0; m < 4; ++m) pre.ssv[ai][m] = ss[u.pm * BM + wr * 64 + fr + ai * HALF + m * 16];
    }
    __device__ __forceinline__ void operator()(const f32x4 (&acc)[2][2][4][2], const Unit& u, int wr, int wc, int fr, int fq, const Pre& pre) const {
        const int row0 = u.pm * BM + wr * 64 + fr, col0 = u.pn * HALF + wc * 32 + 8 * fq;
#pragma unroll
        for (int ai = 0; ai < 2; ++ai)
#pragma unroll
            for (int m = 0; m < 4; ++m) {
                const int row = row0 + ai * HALF + m * 16;
                const float r = rsqrtf(pre.ssv[ai][m] * (1.f / 1024.f) + 1e-6f);
                float o[8];
#pragma unroll
                for (int n = 0; n < 2; ++n)
#pragma unroll
                    for (int j = 0; j < 4; ++j) {
                        const float g = acc[ai][0][m][n][j] * r, up = acc[ai][1][m][n][j] * r;
                        o[4 * n + j] = g * up * __builtin_amdgcn_rcpf(1.f + __expf(-g));
                    }
                u32x4 w; w.x = cvt_pk_bf16(o[0], o[1]); w.y = cvt_pk_bf16(o[2], o[3]); w.z = cvt_pk_bf16(o[4], o[5]); w.w = cvt_pk_bf16(o[6], o[7]);
                st16(H + (size_t)row * 2816 + col0, w);
            }
    }
};
struct EpiQKV {
    static constexpr bool PERM = true, AFTER_DRAIN = false;
    bf16_t* QKV; const float* ss; const float* rope;
    struct Pre { float ssv[2][4]; };
    __device__ __forceinline__ void prefetch(Pre& pre, const Unit& u, int wr, int fr) const {
#pragma unroll
        for (int ai = 0; ai < 2; ++ai)
#pragma unroll
            for (int m = 0; m < 4; ++m) pre.ssv[ai][m] = ss[u.pm * BM + wr * 64 + fr + ai * HALF + m * 16];
    }
    __device__ __forceinline__ void operator()(const f32x4 (&acc)[2][2][4][2], const Unit& u, int wr, int wc, int fr, int fq, const Pre& pre) const {
        const int row0 = u.pm * BM + wr * 64 + fr;
        const int t = u.pn >> 2, head = 4 * (u.pn & 3) + wc;
        bf16_t* base = QKV + (size_t)t * ((size_t)16384 * 1024) + (size_t)head * (2048 * 64) + 8 * fq;
        const float qs = (t == 0) ? 0.125f : 1.f;
#pragma unroll
        for (int ai = 0; ai < 2; ++ai)
#pragma unroll
            for (int m = 0; m < 4; ++m) {
                const int row = row0 + ai * HALF + m * 16;
                const float r = rsqrtf(pre.ssv[ai][m] * (1.f / 1024.f) + 1e-6f) * qs;
                float y1[8], y2[8];
                if (t < 2) {
                    const float* cs = rope + (size_t)(row & 2047) * 64 + 8 * fq;
                    const f32x4 c0 = *(const f32x4*)(cs), c1 = *(const f32x4*)(cs + 4), s0 = *(const f32x4*)(cs + 32), s1 = *(const f32x4*)(cs + 36);
#pragma unroll
                    for (int j = 0; j < 4; ++j) {
                        const float a0 = acc[ai][0][m][0][j] * r, b0 = acc[ai][1][m][0][j] * r, a1 = acc[ai][0][m][1][j] * r, b1 = acc[ai][1][m][1][j] * r;
                        y1[j] = a0 * c0[j] - b0 * s0[j]; y2[j] = a0 * s0[j] + b0 * c0[j];
                        y1[4 + j] = a1 * c1[j] - b1 * s1[j]; y2[4 + j] = a1 * s1[j] + b1 * c1[j];
                    }
                } else {
#pragma unroll
                    for (int j = 0; j < 4; ++j) { y1[j] = acc[ai][0][m][0][j] * r; y2[j] = acc[ai][1][m][0][j] * r; y1[4 + j] = acc[ai][0][m][1][j] * r; y2[4 + j] = acc[ai][1][m][1][j] * r; }
                }
                u32x4 w1, w2;
                w1.x = cvt_pk_bf16(y1[0], y1[1]); w1.y = cvt_pk_bf16(y1[2], y1[3]); w1.z = cvt_pk_bf16(y1[4], y1[5]); w1.w = cvt_pk_bf16(y1[6], y1[7]);
                w2.x = cvt_pk_bf16(y2[0], y2[1]); w2.y = cvt_pk_bf16(y2[2], y2[3]); w2.z = cvt_pk_bf16(y2[4], y2[5]); w2.w = cvt_pk_bf16(y2[6], y2[7]);
                bf16_t* rp = base + (size_t)(row >> 11) * (16 * 2048 * 64) + (size_t)(row & 2047) * 64;
                st16(rp, w1); st16(rp + 32, w2);
            }
    }
};
struct EpiResid {
    static constexpr bool PERM = true, AFTER_DRAIN = false;
    const float* x32; const bf16_t* xb; bf16_t* XB; float* ssout;
    struct Pre {};
    __device__ __forceinline__ void prefetch(Pre&, const Unit&, int, int) const {}
    __device__ __forceinline__ void operator()(const f32x4 (&acc)[2][2][4][2], const Unit& u, int wr, int wc, int fr, int fq, const Pre& pre) const {
        const int row0 = u.pm * BM + wr * 64 + fr, col0 = u.pn * BM + wc * 32 + 8 * fq;
        float srow[2][4];
#pragma unroll
        for (int ai = 0; ai < 2; ++ai) {
            f32x4 xr[4][2][2];
            if (x32) {
#pragma unroll
                for (int m = 0; m < 4; ++m)
#pragma unroll
                    for (int bj = 0; bj < 2; ++bj) { const float* px = x32 + (size_t)(row0 + ai * HALF + m * 16) * 1024 + col0 + bj * HALF; xr[m][bj][0] = *(const f32x4*)(px); xr[m][bj][1] = *(const f32x4*)(px + 4); }
            } else {
                u32x4 xv[4][2];
#pragma unroll
                for (int m = 0; m < 4; ++m)
#pragma unroll
                    for (int bj = 0; bj < 2; ++bj) xv[m][bj] = *(const u32x4*)(xb + (size_t)(row0 + ai * HALF + m * 16) * 1024 + col0 + bj * HALF);
#pragma unroll
                for (int m = 0; m < 4; ++m)
#pragma unroll
                    for (int bj = 0; bj < 2; ++bj) {
                        const u32x4 v = xv[m][bj];
                        xr[m][bj][0] = (f32x4){__builtin_bit_cast(float, v.x << 16), __builtin_bit_cast(float, v.x & 0xffff0000u), __builtin_bit_cast(float, v.y << 16), __builtin_bit_cast(float, v.y & 0xffff0000u)};
                        xr[m][bj][1] = (f32x4){__builtin_bit_cast(float, v.z << 16), __builtin_bit_cast(float, v.z & 0xffff0000u), __builtin_bit_cast(float, v.w << 16), __builtin_bit_cast(float, v.w & 0xffff0000u)};
                    }
            }
#pragma unroll
            for (int m = 0; m < 4; ++m) {
                const size_t off = (size_t)(row0 + ai * HALF + m * 16) * 1024 + col0;
                float s = 0.f;
#pragma unroll
                for (int bj = 0; bj < 2; ++bj) {
                    const f32x4 v0 = acc[ai][bj][m][0] + xr[m][bj][0], v1 = acc[ai][bj][m][1] + xr[m][bj][1];
                    u32x4 w; w.x = cvt_pk_bf16(v0[0], v0[1]); w.y = cvt_pk_bf16(v0[2], v0[3]); w.z = cvt_pk_bf16(v1[0], v1[1]); w.w = cvt_pk_bf16(v1[2], v1[3]);
                    st16(XB + off + bj * HALF, w);
                    const float r0 = __builtin_bit_cast(float, w.x << 16), r1 = __builtin_bit_cast(float, w.x & 0xffff0000u), r2 = __builtin_bit_cast(float, w.y << 16), r3 = __builtin_bit_cast(float, w.y & 0xffff0000u);
                    const float r4 = __builtin_bit_cast(float, w.z << 16), r5 = __builtin_bit_cast(float, w.z & 0xffff0000u), r6 = __builtin_bit_cast(float, w.w << 16), r7 = __builtin_bit_cast(float, w.w & 0xffff0000u);
                    s += (r0 * r0 + r1 * r1) + (r2 * r2 + r3 * r3) + (r4 * r4 + r5 * r5) + (r6 * r6 + r7 * r7);
                }
                srow[ai][m] = s;
            }
        }
#pragma unroll
        for (int ai = 0; ai < 2; ++ai)
#pragma unroll
            for (int m = 0; m < 4; ++m) srow[ai][m] += __shfl_xor(srow[ai][m], 16);
#pragma unroll
        for (int ai = 0; ai < 2; ++ai)
#pragma unroll
            for (int m = 0; m < 4; ++m) srow[ai][m] += __shfl_xor(srow[ai][m], 32);
        if (fq == 0) {
#pragma unroll
            for (int ai = 0; ai < 2; ++ai)
#pragma unroll
                for (int m = 0; m < 4; ++m) atomicAdd(ssout + row0 + ai * HALF + m * 16, srow[ai][m]);
        }
    }
};
}

__device__ __forceinline__ int src_col(int kind, int n) {
    if (kind == 0) return n;
    const int pn = n >> 8, bj = (n >> 7) & 1, c = n & 127;
    if (kind == 1) return bj * 2816 + 128 * pn + c;
    const int t = pn >> 2, head = 4 * (pn & 3) + (c >> 5), i = c & 31;
    return t * 1024 + head * 64 + bj * 32 + i;
}
__device__ __forceinline__ void convert_tile(const float* __restrict__ W, bf16* __restrict__ Bt, int K, int N, const float* __restrict__ gain, int kind, int tile, float* Tl) {
    const int ntn = N >> 8; const int kt = tile / ntn, nt = tile - kt * ntn; const int k0 = kt * 64, n0 = nt * 256;
    const int tid = threadIdx.x;
    {
        f32x4 v[8];
        const int n4 = (tid & 63) * 4; const int sc = src_col(kind, n0 + n4);
#pragma unroll
        for (int i = 0; i < 8; ++i) { const int kk = i * 8 + (tid >> 6); v[i] = *(const f32x4*)(W + (size_t)(k0 + kk) * N + sc); }
        if (gain) {
#pragma unroll
            for (int i = 0; i < 8; ++i) v[i] = v[i] * gain[k0 + i * 8 + (tid >> 6)];
        }
#pragma unroll
        for (int i = 0; i < 8; ++i) { const int kk = i * 8 + (tid >> 6); *(f32x4*)(Tl + kk * 260 + n4) = v[i]; }
    }
    __syncthreads();
    {
        const int n = tid & 255, chalf = tid >> 8;
#pragma unroll
        for (int i = 0; i < 4; ++i) {
            const int c = 2 * i + chalf; const float* sp = Tl + (8 * c) * 260 + n;
            u32x4 o; o.x = pg8::cvt_pk_bf16(sp[0], sp[260]); o.y = pg8::cvt_pk_bf16(sp[520], sp[780]); o.z = pg8::cvt_pk_bf16(sp[1040], sp[1300]); o.w = pg8::cvt_pk_bf16(sp[1560], sp[1820]);
            *(u32x4*)(Bt + (size_t)(n0 + n) * K + k0 + 8 * c) = o;
        }
    }
    __syncthreads();
}

__device__ __forceinline__ void convert_items(const Params& p, unsigned char* smem, int lo, int hi, int first, int stride) {
    float* Tl = (float*)smem;
    for (int item = lo + first; item < hi; item += stride) {
        int t = item; const float* W; bf16* Bt; int K, N, kind; const float* gain;
        if (t < 224) { W = p.w_in_rec; Bt = (bf16*)(p.ws + WS_W_INREC); K = 1024; N = 3584; kind = 0; gain = p.mix_norm; }
        else if ((t -= 224) < 64) { W = p.w_out_rec; Bt = (bf16*)(p.ws + WS_W_OUTREC); K = 1024; N = 1024; kind = 0; gain = nullptr; }
        else if ((t -= 64) < 352) { W = p.w_ffn_in; Bt = (bf16*)(p.ws + WS_W_FFNIN0); K = 1024; N = 5632; kind = 1; gain = p.ffn_norm; }
        else if ((t -= 352) < 176) { W = p.w_ffn_out; Bt = (bf16*)(p.ws + WS_W_FFNOUT0); K = 2816; N = 1024; kind = 0; gain = nullptr; }
        else if ((t -= 176) < 192) { W = p.w_qkv; Bt = (bf16*)(p.ws + WS_W_QKV); K = 1024; N = 3072; kind = 2; gain = p.mix_norm + 1024; }
        else if ((t -= 192) < 64) { W = p.w_o; Bt = (bf16*)(p.ws + WS_W_O); K = 1024; N = 1024; kind = 0; gain = nullptr; }
        else if ((t -= 64) < 352) { W = p.w_ffn_in + (size_t)1024 * 5632; Bt = (bf16*)(p.ws + WS_W_FFNIN1); K = 1024; N = 5632; kind = 1; gain = p.ffn_norm + 1024; }
        else { t -= 352; W = p.w_ffn_out + (size_t)2816 * 1024; Bt = (bf16*)(p.ws + WS_W_FFNOUT1); K = 2816; N = 1024; kind = 0; gain = nullptr; }
        convert_tile(W, Bt, K, N, gain, kind, t, Tl);
    }
}
#ifndef CONV_SPLIT2
#define CONV_SPLIT2 816
#endif
#ifndef CONV_SPLIT
#define CONV_SPLIT 224
#endif

__device__ __forceinline__ void phase_prologue(const Params& p, unsigned char* smem) {
    const int tid = threadIdx.x, lane = tid & 63, wave = tid >> 6;
    convert_items(p, smem, 0, CONV_SPLIT, blockIdx.x, gridDim.x);
    {
        float* ss = (float*)(p.ws + WS_SS); bf16* XB = (bf16*)(p.ws + WS_XB);
        for (int row = blockIdx.x * 8 + wave; row < T_TOK; row += gridDim.x * 8) {
            const f32x4* xr = (const f32x4*)(p.x + (size_t)row * 1024) + lane;
            f32x4 v[4]; float s = 0.f;
#pragma unroll
            for (int j = 0; j < 4; ++j) { v[j] = xr[64 * j]; s += (v[j][0] * v[j][0] + v[j][1] * v[j][1]) + (v[j][2] * v[j][2] + v[j][3] * v[j][3]); }
            s = wave_sum(s);
            u32x2* o = (u32x2*)(XB + (size_t)row * 1024) + lane;
#pragma unroll
            for (int j = 0; j < 4; ++j) { u32x2 w; w.x = pk2(v[j][0], v[j][1]); w.y = pk2(v[j][2], v[j][3]); o[64 * j] = w; }
            if (lane == 0) ss[row] = s;
        }
        for (int i = blockIdx.x * 512 + tid; i < 4 * T_TOK; i += gridDim.x * 512) ss[T_TOK + i] = 0.f;
    }
    {
        float* rope = (float*)(p.ws + WS_ROPE);
        for (int i = blockIdx.x * 512 + tid; i < SEQ * 32; i += gridDim.x * 512) {
            const int pos = i >> 5, f = i & 31;
            const float freq = exp2f(-(float)f * (13.287712379549449f / 32.f));
            const float ang = (float)pos * freq;
            const double a = (double)ang; const double kq = rint(a * 0.15915494309189535); const float r = (float)(a - kq * 6.283185307179586);
            rope[pos * 64 + f] = __cosf(r); rope[pos * 64 + 32 + f] = __sinf(r);
        }
    }
}

__device__ __forceinline__ float hgrn_lb_of(const Params& p, int ch) {
    const float a = p.hgrn_lb[ch], b = p.hgrn_lb[512 + ch], c = p.hgrn_lb[1024 + ch];
    const float m = fmaxf(a, fmaxf(b, c)); const float ea = __expf(a - m), eb = __expf(b - m), ec = __expf(c - m);
    return eb * __builtin_amdgcn_rcpf(ea + eb + ec);
}

__device__ __forceinline__ void phase_conv(const Params& p) {
    const bf16* PROJ = (const bf16*)(p.ws + WS_BIG); bf16* MIX = (bf16*)(p.ws + WS_MIX);
    const int tid = threadIdx.x;
    for (int task = blockIdx.x * 512 + tid; task < T_TOK * 64; task += gridDim.x * 512) {
        const int tok = task >> 6, c8 = (task & 63) * 8; const int pos = tok & (SEQ - 1);
        const bf16* row = PROJ + (size_t)tok * NPROJ + c8;
        const u32x4 bg = *(const u32x4*)(row);
        float y[8];
#pragma unroll
        for (int e = 0; e < 8; ++e) y[e] = 0.f;
#pragma unroll
        for (int j = 0; j < 3; ++j) {
            const int back = 2 - j;
            if (pos >= back) {
                const bf16* rj = row - (size_t)back * NPROJ;
                const u32x4 cgv = *(const u32x4*)(rj + 512), vcv = *(const u32x4*)(rj + 1024);
                const f32x4 w0 = *(const f32x4*)(p.conv_w + j * 512 + c8), w1 = *(const f32x4*)(p.conv_w + j * 512 + c8 + 4);
#pragma unroll
                for (int q = 0; q < 4; ++q) {
                    const float wl = (q < 2) ? w0[2 * q] : w1[2 * q - 4], wh = (q < 2) ? w0[2 * q + 1] : w1[2 * q - 3];
                    y[2 * q] += wl * bflo(cgv[q]) * bflo(vcv[q]);
                    y[2 * q + 1] += wh * bfhi(cgv[q]) * bfhi(vcv[q]);
                }
            }
        }
        u32x4 o;
#pragma unroll
        for (int q = 0; q < 4; ++q) o[q] = pk2(y[2 * q] * bflo(bg[q]), y[2 * q + 1] * bfhi(bg[q]));
        *(u32x4*)(MIX + (size_t)tok * 1024 + c8) = o;
    }
}

#define MFMA16(a, b, c) __builtin_amdgcn_mfma_f32_16x16x32_bf16((a), (b), (c), 0, 0, 0)
#define MFMA32(a, b, c) __builtin_amdgcn_mfma_f32_32x32x16_bf16((a), (b), (c), 0, 0, 0)

__device__ __forceinline__ void phase_hgrn_a(const Params& p, unsigned char* smem) {
    const bf16* PROJ = (const bf16*)(p.ws + WS_BIG); bf16* UT = (bf16*)p.out; float* DEC = (float*)(p.ws + WS_DEC);
    bf16* KgT = (bf16*)smem;
    bf16* VT = KgT + 128 * 72;
    float* part = (float*)(smem + 2 * 128 * 72 * 2);
    const int tid = threadIdx.x, lane = tid & 63, wave = tid >> 6, fr = lane & 15, fq = lane >> 4;
    const int k = tid & 127, qd = tid >> 7;
    for (int item = blockIdx.x; item < 1024; item += gridDim.x) {
        const int bh = item >> 5, c = item & 31, b = bh >> 2, h = bh & 3;
        const int t0 = b * SEQ + c * 64;
        const float lb = hgrn_lb_of(p, h * 128 + k);
        const bf16* zp = PROJ + (size_t)(t0 + 16 * qd) * NPROJ + 2048 + h * 128 + k;
        float G[16], kk[16], vv[16];
        float run = 0.f;
#pragma unroll
        for (int i = 0; i < 16; ++i) {
            const float z = bf2f(zp[(size_t)i * NPROJ]); const float iv = bf2f(zp[(size_t)i * NPROJ + 512]);
            const float sg = sigmoidf_(z); const float f = lb + (1.f - lb) * sg;
            run += __logf(f); G[i] = run; kk[i] = 1.f - f; vv[i] = iv * sigmoidf_(iv);
        }
        part[qd * 128 + k] = run;
        __syncthreads();
        float off = 0.f, tot = 0.f;
#pragma unroll
        for (int q = 0; q < 4; ++q) { const float pv = part[q * 128 + k]; tot += pv; if (q < qd) off += pv; }
        {
            unsigned kw[8], vw[8];
#pragma unroll
            for (int i = 0; i < 8; ++i) {
                const float g0 = G[2 * i] + off, g1 = G[2 * i + 1] + off;
                kw[i] = pk2(kk[2 * i] * __expf(tot - g0), kk[2 * i + 1] * __expf(tot - g1));
                vw[i] = pk2(vv[2 * i], vv[2 * i + 1]);
            }
            u32x4* kd = (u32x4*)(KgT + k * 72 + 16 * qd); u32x4* vd = (u32x4*)(VT + k * 72 + 16 * qd);
            kd[0] = (u32x4){kw[0], kw[1], kw[2], kw[3]}; kd[1] = (u32x4){kw[4], kw[5], kw[6], kw[7]};
            vd[0] = (u32x4){vw[0], vw[1], vw[2], vw[3]}; vd[1] = (u32x4){vw[4], vw[5], vw[6], vw[7]};
        }
        if (qd == 0) DEC[item * 128 + k] = __expf(tot);
        __syncthreads();
        {
            const int mt = wave;
            bf16x8 a[2];
#pragma unroll
            for (int ks = 0; ks < 2; ++ks) a[ks] = *(const bf16x8*)(KgT + (16 * mt + fr) * 72 + 32 * ks + 8 * fq);
            bf16* ub = UT + (size_t)item * 16384 + 16 * mt + 4 * fq;
#pragma unroll
            for (int nt = 0; nt < 8; ++nt) {
                f32x4 acc = {0.f, 0.f, 0.f, 0.f};
#pragma unroll
                for (int ks = 0; ks < 2; ++ks) { const bf16x8 bb = *(const bf16x8*)(VT + (16 * nt + fr) * 72 + 32 * ks + 8 * fq); acc = MFMA16(a[ks], bb, acc); }
                { u32x2 w; w.x = pk2(acc[0], acc[1]); w.y = pk2(acc[2], acc[3]); *(u32x2*)(ub + (size_t)(16 * nt + fr) * 128) = w; }
            }
        }
        __syncthreads();
    }
}

__device__ __forceinline__ void phase_hgrn_b(const Params& p) {
    const bf16* UT = (const bf16*)p.out; const float* DEC = (const float*)(p.ws + WS_DEC); bf16* SP = (bf16*)p.out + (size_t)T_TOK * 1024;
    for (int e4 = blockIdx.x * 512 + threadIdx.x; e4 < 32 * 4096; e4 += gridDim.x * 512) {
        const int bh = e4 >> 12, r = e4 & 4095, k4 = (r & 31) * 4;
        f32x4 S = {0.f, 0.f, 0.f, 0.f};
#pragma unroll 8
        for (int c = 0; c < 32; ++c) {
            const int item = bh * 32 + c;
            u32x2 w; w.x = pk2(S[0], S[1]); w.y = pk2(S[2], S[3]);
            *(u32x2*)(SP + (size_t)item * 16384 + r * 4) = w;
            const f32x4 d = *(const f32x4*)(DEC + item * 128 + k4); const u32x2 uw = *(const u32x2*)(UT + (size_t)item * 16384 + r * 4); const f32x4 u = {bflo(uw.x), bfhi(uw.x), bflo(uw.y), bfhi(uw.y)};
            S = d * S + u;
        }
    }
}

__device__ __forceinline__ void phase_hgrn_c(const Params& p, unsigned char* smem) {
    const bf16* PROJ = (const bf16*)(p.ws + WS_BIG); const bf16* SP = (const bf16*)p.out + (size_t)T_TOK * 1024; bf16* MIX = (bf16*)(p.ws + WS_MIX);
    bf16* Am = (bf16*)smem;
    bf16* Bm = Am + 64 * 136;
    bf16* Qg = Bm + 64 * 136;
    bf16* VT = Qg + 64 * 136;
    bf16* P = VT + 128 * 72;
    float* part = (float*)(smem + 3 * 17408 + 18432 + 9216);
    float* rowss = part + 512;
    const int tid = threadIdx.x, lane = tid & 63, wave = tid >> 6, fr = lane & 15, fq = lane >> 4;
    const int k = tid & 127, qd = tid >> 7;
    typedef unsigned short us2 __attribute__((ext_vector_type(2)));
    us2 zi[16], qq[8];
    if ((int)blockIdx.x < 1024) {
        const int item = blockIdx.x; const int bh = item >> 5, c = item & 31, b = bh >> 2, h = bh & 3;
        const bf16* zp = PROJ + (size_t)(b * SEQ + c * 64 + 16 * qd) * NPROJ + 2048 + h * 128 + k;
#pragma unroll
        for (int i = 0; i < 16; ++i) { zi[i].x = zp[(size_t)i * NPROJ]; zi[i].y = zp[(size_t)i * NPROJ + 512]; if (i & 1) qq[i >> 1].y = zp[(size_t)i * NPROJ - 512]; else qq[i >> 1].x = zp[(size_t)i * NPROJ - 512]; }
    }
    for (int item = blockIdx.x; item < 1024; item += gridDim.x) {
        const int bh = item >> 5, c = item & 31, b = bh >> 2, h = bh & 3;
        const int t0 = b * SEQ + c * 64;
        const float lb = hgrn_lb_of(p, h * 128 + k);
        float G[16], kk[16], vv[16], qv[16];
        float run = 0.f;
#pragma unroll
        for (int i = 0; i < 16; ++i) {
            const float z = bf2f(zi[i].x); const float iv = bf2f(zi[i].y); qv[i] = bf2f((i & 1) ? qq[i >> 1].y : qq[i >> 1].x);
            const float sg = sigmoidf_(z); const float f = lb + (1.f - lb) * sg;
            run += __logf(f); G[i] = run; kk[i] = 1.f - f; vv[i] = iv * sigmoidf_(iv);
        }
        part[qd * 128 + k] = run;
#pragma unroll
        for (int i = 0; i < 16; ++i) {
            const int t = 16 * qd + i;
            Am[t * 136 + k] = (bf16)f2bf(qv[i] * __expf(G[i])); Bm[t * 136 + k] = (bf16)f2bf(kk[i] * __expf(run - G[i]));
        }
        for (int i = tid; i < 2304; i += 512) ((unsigned*)P)[i] = 0u;
        __syncthreads();
        float off = 0.f;
#pragma unroll
        for (int q = 0; q < 4; ++q) { const float pv = part[q * 128 + k]; if (q < qd) off += pv; }
        {
            unsigned vw[8];
#pragma unroll
            for (int i = 0; i < 16; ++i) {
                const float g = G[i] + off; const int t = 16 * qd + i;
                Qg[t * 136 + k] = (bf16)f2bf(qv[i] * __expf(g));
            }
#pragma unroll
            for (int i = 0; i < 8; ++i) vw[i] = pk2(vv[2 * i], vv[2 * i + 1]);
            u32x4* vd = (u32x4*)(VT + k * 72 + 16 * qd);
            vd[0] = (u32x4){vw[0], vw[1], vw[2], vw[3]}; vd[1] = (u32x4){vw[4], vw[5], vw[6], vw[7]};
        }
        __syncthreads();
        {
            const int nitem = item + gridDim.x;
            if (nitem < 1024) {
                const int nbh = nitem >> 5, nc = nitem & 31, nb = nbh >> 2, nh = nbh & 3;
                const bf16* zp = PROJ + (size_t)(nb * SEQ + nc * 64 + 16 * qd) * NPROJ + 2048 + nh * 128 + k;
#pragma unroll
                for (int i = 0; i < 16; ++i) { zi[i].x = zp[(size_t)i * NPROJ]; zi[i].y = zp[(size_t)i * NPROJ + 512]; if (i & 1) qq[i >> 1].y = zp[(size_t)i * NPROJ - 512]; else qq[i >> 1].x = zp[(size_t)i * NPROJ - 512]; }
            }
        }
        const int tt = wave & 3, vh = wave >> 2;
        bf16x8 sbf[4][4]; unsigned short gg[4][4];
        {
            const bf16* spb = SP + (size_t)item * 16384;
#pragma unroll
            for (int nt = 0; nt < 4; ++nt) {
                const int v = 16 * (4 * vh + nt) + fr;
#pragma unroll
                for (int ks = 0; ks < 4; ++ks) sbf[nt][ks] = *(const bf16x8*)(spb + (size_t)v * 128 + 32 * ks + 8 * fq);
#pragma unroll
                for (int j = 0; j < 4; ++j) gg[nt][j] = PROJ[(size_t)(t0 + 16 * tt + 4 * fq + j) * NPROJ + 3072 + h * 128 + v];
            }
        }
        for (int sb = wave; sb < 10; sb += 8) {
            const int I = (sb >= 6) ? 3 : (sb >= 3) ? 2 : (sb >= 1) ? 1 : 0; const int J = sb - (I * (I + 1)) / 2;
            f32x4 acc = {0.f, 0.f, 0.f, 0.f};
#pragma unroll
            for (int ks = 0; ks < 4; ++ks) {
                const int kb = 32 * ks + 8 * fq;
                const bf16x8 av = *(const bf16x8*)(Am + (16 * I + fr) * 136 + kb);
                u32x4 bw = *(const u32x4*)(Bm + (16 * J + fr) * 136 + kb);
                if (J != I - 1) {
                    f32x4 e0, e1;
                    if (J == I) { e0 = -*(const f32x4*)(part + I * 128 + kb); e1 = -*(const f32x4*)(part + I * 128 + kb + 4); }
                    else {
                        e0 = *(const f32x4*)(part + (J + 1) * 128 + kb); e1 = *(const f32x4*)(part + (J + 1) * 128 + kb + 4);
                        if (I - J == 3) { e0 += *(const f32x4*)(part + (J + 2) * 128 + kb); e1 += *(const f32x4*)(part + (J + 2) * 128 + kb + 4); }
                    }
#pragma unroll
                    for (int e = 0; e < 4; ++e) {
                        const float xl = (e < 2) ? e0[2 * e] : e1[2 * e - 4], xh = (e < 2) ? e0[2 * e + 1] : e1[2 * e - 3];
                        bw[e] = pk2(bflo(bw[e]) * __expf(fminf(xl, 80.f)), bfhi(bw[e]) * __expf(fminf(xh, 80.f)));
                    }
                }
                acc = MFMA16(av, __builtin_bit_cast(bf16x8, bw), acc);
            }
#pragma unroll
            for (int j = 0; j < 4; ++j) { const int t = 16 * I + 4 * fq + j, s = 16 * J + fr; P[t * 72 + s] = (bf16)f2bf((s <= t) ? acc[j] : 0.f); }
        }
        __syncthreads();
        f32x4 o[4];
        {
            bf16x8 aq[4], ap[2];
#pragma unroll
            for (int ks = 0; ks < 4; ++ks) aq[ks] = *(const bf16x8*)(Qg + (16 * tt + fr) * 136 + 32 * ks + 8 * fq);
#pragma unroll
            for (int ks = 0; ks < 2; ++ks) ap[ks] = *(const bf16x8*)(P + (16 * tt + fr) * 72 + 32 * ks + 8 * fq);
#pragma unroll
            for (int nt = 0; nt < 4; ++nt) {
                const int v = 16 * (4 * vh + nt) + fr;
                f32x4 acc = {0.f, 0.f, 0.f, 0.f};
#pragma unroll
                for (int ks = 0; ks < 4; ++ks) acc = MFMA16(aq[ks], sbf[nt][ks], acc);
#pragma unroll
                for (int ks = 0; ks < 2; ++ks) { const bf16x8 bb = *(const bf16x8*)(VT + v * 72 + 32 * ks + 8 * fq); acc = MFMA16(ap[ks], bb, acc); }
                o[nt] = acc;
            }
        }
        {
            float s4[4];
#pragma unroll
            for (int j = 0; j < 4; ++j) {
                float s = o[0][j] * o[0][j] + o[1][j] * o[1][j] + o[2][j] * o[2][j] + o[3][j] * o[3][j];
                s += __shfl_xor(s, 1); s += __shfl_xor(s, 2); s += __shfl_xor(s, 4); s += __shfl_xor(s, 8);
                s4[j] = s;
            }
            if (fr == 0) {
#pragma unroll
                for (int j = 0; j < 4; ++j) rowss[(16 * tt + 4 * fq + j) * 2 + vh] = s4[j];
            }
        }
        __syncthreads();
#pragma unroll
        for (int j = 0; j < 4; ++j) {
            const int t = 16 * tt + 4 * fq + j;
            const float rs = rsqrtf((rowss[t * 2] + rowss[t * 2 + 1]) * (1.f / 128.f) + RMS_EPS);
#pragma unroll
            for (int nt = 0; nt < 4; ++nt) {
                const int v = 16 * (4 * vh + nt) + fr;
                const float g = bf2f(gg[nt][j]);
                const float val = o[nt][j] * rs * p.hgrn_norm[v] * (g * sigmoidf_(g));
                MIX[(size_t)(t0 + t) * 1024 + 512 + h * 128 + v] = (bf16)f2bf(val);
            }
        }
        __syncthreads();
    }
}

__device__ __forceinline__ int crow(int reg, int hi) { return (reg & 3) + 8 * (reg >> 2) + 4 * hi; }
constexpr float LOG2E = 1.4426950408889634f;

typedef short v4i16_t __attribute__((ext_vector_type(4)));
__device__ __forceinline__ u32x2 vtr_read(const unsigned char* pl) {
    return __builtin_bit_cast(u32x2, __builtin_amdgcn_ds_read_tr16_b64_v4i16((PG8_LAS v4i16_t*)pl));
}

#define ATT3_ISSUE_LOADS(BH, D, R, N) do { _Pragma("unroll") for (int i = 0; i < 8; ++i) { \
        const int chunk = i * 256 + gt, row = chunk >> 3, ch = chunk & 7; \
        const int kidx = 128 * ((N) - 1) + row; \
        kv[i] = (u32x4){0u, 0u, 0u, 0u}; vv[i] = (u32x4){0u, 0u, 0u, 0u}; \
        if (kidx >= 0) { const size_t off = ((size_t)(BH) * 2048 + kidx * (D) + (R)) * 64 + ch * 8; kv[i] = *(const u32x4*)(K + off); vv[i] = *(const u32x4*)(V + off); } } } while (0)
__device__ __forceinline__ void att3_job(int gp, int grp, int& bh, int& br, int& d, int& r, int& n) {
    bh = gp / 24; const int job = 2 * (gp - bh * 24) + grp;
    if (job < 16) { br = 0; d = 1; r = 0; n = job; }
    else if (job < 32) { br = 1; d = 4; r = (job - 16) >> 2; n = (job - 16) & 3; }
    else { br = 2; d = 16; r = job - 32; n = 0; }
}
template <int FIRST> __device__ __forceinline__ void att3_tiles(const unsigned char* kbase, const unsigned char* vbase, const bf16x8 (&qf)[4], int c, int hi,
                                                                float& mrun, float& lsum, f32x16& o0, f32x16& o1) {
    f32x16 scn;
#pragma unroll
    for (int j = 0; j < 16; ++j) scn[j] = 0.f;
    {
        const unsigned char* kp = kbase + (32 * FIRST) * 144;
#pragma unroll
        for (int ks = 0; ks < 4; ++ks) { const bf16x8 kf = *(const bf16x8*)(kp + 32 * ks); scn = MFMA32(kf, qf[ks], scn); }
    }
    bf16x8 pbp[2];
#pragma unroll
    for (int i = FIRST; i < 5; ++i) {
        f32x16 sc = scn;
        if (i + 1 < 5) {
#pragma unroll
            for (int j = 0; j < 16; ++j) scn[j] = 0.f;
            const unsigned char* kp = kbase + (32 * (i + 1)) * 144;
#pragma unroll
            for (int ks = 0; ks < 4; ++ks) { const bf16x8 kf = *(const bf16x8*)(kp + 32 * ks); scn = MFMA32(kf, qf[ks], scn); }
        }
        if (i > FIRST) {
            const unsigned char* vp = vbase + (32 * (i - 1)) * 144;
#pragma unroll
            for (int ks = 0; ks < 2; ++ks) {
                const u32x2 a00 = vtr_read(vp + (16 * ks) * 144), a01 = vtr_read(vp + (16 * ks + 8) * 144);
                const u32x2 a10 = vtr_read(vp + (16 * ks) * 144 + 64), a11 = vtr_read(vp + (16 * ks + 8) * 144 + 64);
                const u32x4 A0 = {a00.x, a00.y, a01.x, a01.y}, A1 = {a10.x, a10.y, a11.x, a11.y};
                o0 = MFMA32(__builtin_bit_cast(bf16x8, A0), pbp[ks], o0);
                o1 = MFMA32(__builtin_bit_cast(bf16x8, A1), pbp[ks], o1);
            }
        }
        if (i == 0) {
#pragma unroll
            for (int j = 0; j < 16; ++j) sc[j] = (crow(j, hi) >= c) ? sc[j] : -1e30f;
        }
        if (i == 4) {
#pragma unroll
            for (int j = 0; j < 16; ++j) sc[j] = (crow(j, hi) <= c) ? sc[j] : -1e30f;
        }
        float mx = sc[0];
#pragma unroll
        for (int j = 1; j < 16; ++j) mx = fmaxf(mx, sc[j]);
        mx = xor32_max(mx);
        const float mnew = fmaxf(mrun, mx);
        const float alpha = __builtin_amdgcn_exp2f((mrun - mnew) * LOG2E);
        const float mL = mnew * LOG2E;
        float rs = 0.f;
#pragma unroll
        for (int j = 0; j < 16; ++j) { const float pj = __builtin_amdgcn_exp2f(sc[j] * LOG2E - mL); sc[j] = pj; rs += pj; }
        rs = xor32_sum(rs);
        lsum = lsum * alpha + rs; mrun = mnew;
#pragma unroll
        for (int ks = 0; ks < 2; ++ks) {
            u32x4 w; w.x = pk2(sc[8 * ks], sc[8 * ks + 1]); w.y = pk2(sc[8 * ks + 2], sc[8 * ks + 3]);
            w.z = pk2(sc[8 * ks + 4], sc[8 * ks + 5]); w.w = pk2(sc[8 * ks + 6], sc[8 * ks + 7]);
            pbp[ks] = __builtin_bit_cast(bf16x8, w);
        }
#pragma unroll
        for (int j = 0; j < 16; ++j) { o0[j] *= alpha; o1[j] *= alpha; }
    }
    {
        const unsigned char* vp = vbase + (32 * 4) * 144;
#pragma unroll
        for (int ks = 0; ks < 2; ++ks) {
            const u32x2 a00 = vtr_read(vp + (16 * ks) * 144), a01 = vtr_read(vp + (16 * ks + 8) * 144);
            const u32x2 a10 = vtr_read(vp + (16 * ks) * 144 + 64), a11 = vtr_read(vp + (16 * ks + 8) * 144 + 64);
            const u32x4 A0 = {a00.x, a00.y, a01.x, a01.y}, A1 = {a10.x, a10.y, a11.x, a11.y};
            o0 = MFMA32(__builtin_bit_cast(bf16x8, A0), pbp[ks], o0);
            o1 = MFMA32(__builtin_bit_cast(bf16x8, A1), pbp[ks], o1);
        }
    }
}
__device__ __forceinline__ void phase_attn3(const Params& p, unsigned char* smem) {
    const bf16* Q = (const bf16*)(p.ws + WS_BIG); const bf16* K = Q + (size_t)T_TOK * 1024; const bf16* V = K + (size_t)T_TOK * 1024;
    float* LSE = (float*)(p.ws + WS_LSE);
    const int tid = threadIdx.x, lane = tid & 63, wave = tid >> 6, c = lane & 31, hi = lane >> 5;
    const int grp = wave >> 2, w4 = wave & 3, gt = tid & 255;
    unsigned char* Kl = smem + grp * 73728; unsigned char* Vl = Kl + 36864;
    const int trl = 144 * ((lane & 15) >> 2) + 32 * ((lane >> 4) & 1) + 8 * (lane & 3) + 144 * 4 * hi;
    const int G = gridDim.x; const bool xcdmap = (G == 256);
    const int xcd = blockIdx.x & 7, li = blockIdx.x >> 3;
    const int cnt = xcdmap ? 12 : ((3072 - (int)blockIdx.x + G - 1) / G);
#define ATT3_GP(i) (xcdmap ? (xcd * 384 + li + 32 * (i)) : ((int)blockIdx.x + G * (i)))
    if (cnt <= 0) return;
    u32x4 kv[8], vv[8];
    int bh, br, d, r, n;
    att3_job(ATT3_GP(0), grp, bh, br, d, r, n);
    ATT3_ISSUE_LOADS(bh, d, r, n);
    for (int it = 0; it < cnt; ++it) {
        const int qi0 = 128 * n + 32 * w4, rowoff = 128 - 128 * n;
#pragma unroll
        for (int i = 0; i < 8; ++i) {
            const int chunk = i * 256 + gt, row = chunk >> 3, ch = chunk & 7;
            *(u32x4*)(Kl + row * 144 + ch * 16) = kv[i]; *(u32x4*)(Vl + row * 144 + ch * 16) = vv[i];
        }
        const int b = bh >> 4, h = bh & 15;
        const int tok = b * SEQ + (qi0 + c) * d + r;
        bf16x8 qf[4];
        {
            const bf16* qp = Q + ((size_t)bh * 2048 + (qi0 + c) * d + r) * 64 + 8 * hi;
#pragma unroll
            for (int ks = 0; ks < 4; ++ks) qf[ks] = *(const bf16x8*)(qp + 16 * ks);
        }
        const int cbr = br;
        __syncthreads();
        if (it + 1 < cnt) { att3_job(ATT3_GP(it + 1), grp, bh, br, d, r, n); ATT3_ISSUE_LOADS(bh, d, r, n); }
        float mrun = -1e30f, lsum = 0.f;
        f32x16 o0, o1;
#pragma unroll
        for (int j = 0; j < 16; ++j) { o0[j] = 0.f; o1[j] = 0.f; }
        {
            const int first = (qi0 >= 128) ? 0 : (4 - (qi0 >> 5));
            const unsigned char* kbase = Kl + (rowoff + qi0 - 128 + c) * 144 + 16 * hi;
            const unsigned char* vbase = Vl + (rowoff + qi0 - 128) * 144 + trl;
            switch (first) {
            case 0: att3_tiles<0>(kbase, vbase, qf, c, hi, mrun, lsum, o0, o1); break;
            case 1: att3_tiles<1>(kbase, vbase, qf, c, hi, mrun, lsum, o0, o1); break;
            case 2: att3_tiles<2>(kbase, vbase, qf, c, hi, mrun, lsum, o0, o1); break;
            case 3: att3_tiles<3>(kbase, vbase, qf, c, hi, mrun, lsum, o0, o1); break;
            default: att3_tiles<4>(kbase, vbase, qf, c, hi, mrun, lsum, o0, o1); break;
            }
        }
        {
            bf16* OB = (cbr == 2) ? (bf16*)(p.ws + WS_OB2) : ((bf16*)p.out + (size_t)cbr * ((size_t)T_TOK * 1024));
            const float inv = __builtin_amdgcn_rcpf(lsum);
            bf16* op = OB + (size_t)tok * 1024 + h * 64 + 4 * hi;
#pragma unroll
            for (int q = 0; q < 4; ++q) {
                u32x2 w0, w1;
                w0.x = pg8::cvt_pk_bf16(o0[4 * q] * inv, o0[4 * q + 1] * inv); w0.y = pg8::cvt_pk_bf16(o0[4 * q + 2] * inv, o0[4 * q + 3] * inv);
                w1.x = pg8::cvt_pk_bf16(o1[4 * q] * inv, o1[4 * q + 1] * inv); w1.y = pg8::cvt_pk_bf16(o1[4 * q + 2] * inv, o1[4 * q + 3] * inv);
                *(u32x2*)(op + 8 * q) = w0; *(u32x2*)(op + 32 + 8 * q) = w1;
            }
            if (hi == 0) LSE[(size_t)cbr * (T_TOK * 16) + (size_t)tok * 16 + h] = mrun * LOG2E + __builtin_amdgcn_logf(lsum);
        }
        __syncthreads();
    }
}
__device__ __forceinline__ void phase_attn_merge(const Params& p) {
    const bf16* O0 = (const bf16*)p.out; const bf16* O1 = O0 + (size_t)T_TOK * 1024; const bf16* O2 = (const bf16*)(p.ws + WS_OB2);
    const float* LSE = (const float*)(p.ws + WS_LSE); bf16* ATT = (bf16*)(p.ws + WS_MIX);
    for (int i = blockIdx.x * 512 + threadIdx.x; i < T_TOK * 128; i += gridDim.x * 512) {
        const int tok = i >> 7, c8 = (i & 127) * 8, h = c8 >> 6;
        const float l0 = LSE[(size_t)tok * 16 + h], l1 = LSE[(size_t)T_TOK * 16 + (size_t)tok * 16 + h], l2 = LSE[(size_t)2 * T_TOK * 16 + (size_t)tok * 16 + h];
        const float M = fmaxf(l0, fmaxf(l1, l2));
        const float e0 = __builtin_amdgcn_exp2f(l0 - M), e1 = __builtin_amdgcn_exp2f(l1 - M), e2 = __builtin_amdgcn_exp2f(l2 - M);
        const float isum = __builtin_amdgcn_rcpf(e0 + e1 + e2); const float w0 = e0 * isum, w1 = e1 * isum, w2 = e2 * isum;
        const size_t off = (size_t)tok * 1024 + c8;
        const u32x4 a = *(const u32x4*)(O0 + off), b = *(const u32x4*)(O1 + off), cc = *(const u32x4*)(O2 + off);
        u32x4 o;
#pragma unroll
        for (int q = 0; q < 4; ++q) o[q] = pg8::cvt_pk_bf16(bflo(a[q]) * w0 + bflo(b[q]) * w1 + bflo(cc[q]) * w2, bfhi(a[q]) * w0 + bfhi(b[q]) * w1 + bfhi(cc[q]) * w2);
        *(u32x4*)(ATT + off) = o;
    }
}

__device__ __forceinline__ void phase_final(const Params& p) {
    const float* ss = (const float*)(p.ws + WS_SS) + 4 * T_TOK; const bf16* XB = (const bf16*)(p.ws + WS_XB);
    for (int i = blockIdx.x * 512 + threadIdx.x; i < T_TOK * 128; i += gridDim.x * 512) {
        const int row = i >> 7, c8 = (i & 127) * 8;
        const float r = rsqrtf(ss[row] * (1.f / 1024.f) + RMS_EPS);
        const u32x4 xv = *(const u32x4*)(XB + (size_t)row * 1024 + c8);
        const f32x4 g0 = *(const f32x4*)(p.final_norm + c8), g1 = *(const f32x4*)(p.final_norm + c8 + 4);
        f32x4 o0 = {bflo(xv.x), bfhi(xv.x), bflo(xv.y), bfhi(xv.y)}, o1 = {bflo(xv.z), bfhi(xv.z), bflo(xv.w), bfhi(xv.w)};
        *(f32x4*)(p.out + (size_t)row * 1024 + c8) = o0 * r * g0; *(f32x4*)(p.out + (size_t)row * 1024 + c8 + 4) = o1 * r * g1;
    }
}

#define XB_TMO      128
#define XB_XCNT(j)  (256  + 64 * (j))
#define XB_XSUB(j)  (1280 + 64 * (j))
#define XB_XGEN(j)  (2304 + 64 * (j))
#define XB_TOP      3328
#define XB_TOPGEN   3392
#define XCD_BAR_WORDS 3456
#define XB_SPIN_CAP (1u << 18)

__device__ __forceinline__ unsigned xb_ld(unsigned* p)              { return __hip_atomic_load(p, __ATOMIC_RELAXED, __HIP_MEMORY_SCOPE_AGENT); }
__device__ __forceinline__ unsigned xb_add(unsigned* p, unsigned v) { return __hip_atomic_fetch_add(p, v, __ATOMIC_RELAXED, __HIP_MEMORY_SCOPE_AGENT); }
__device__ __forceinline__ unsigned xb_xcc_id() { return (unsigned)__builtin_amdgcn_s_getreg((3 << 11) | 20) & 0xFu; }
#define XB_SPIN(cond, bar) do { unsigned _sp = 0; while (cond) { __builtin_amdgcn_s_sleep(1); \
    if ((++_sp & 255u) == 0u) { if (xb_ld(&(bar)[XB_TMO])) break; if (_sp > XB_SPIN_CAP) { atomicAdd(&(bar)[XB_TMO], 1u); break; } } } } while (0)

struct XcdBarrier {
    unsigned* bar; unsigned x;
    volatile PG8_LAS unsigned* st;
};

__device__ __forceinline__ XcdBarrier xcd_barrier_post(unsigned* bar, volatile PG8_LAS unsigned* st) {
    XcdBarrier b; b.bar = bar; b.x = xb_xcc_id(); b.st = st;
    if (threadIdx.x == 0) (void)xb_add(&bar[XB_XCNT(b.x)], 1u);
    return b;
}
__device__ __forceinline__ void xcd_barrier_complete(unsigned* bar, unsigned x, unsigned& nloc, unsigned& nx) {
    const unsigned G = gridDim.x * gridDim.y * gridDim.z;
    unsigned sum, cnt, mine, sp = 0u;
    for (;;) {
        sum = 0u; cnt = 0u; mine = 0u;
#pragma unroll
        for (unsigned j = 0; j < 16; ++j) { const unsigned c = xb_ld(&bar[XB_XCNT(j)]); sum += c; cnt += (c > 0u) ? 1u : 0u; mine = (j == x) ? c : mine; }
        if (sum == G) break;
        __builtin_amdgcn_s_sleep(1);
        if ((++sp & 255u) == 0u) { if (xb_ld(&bar[XB_TMO])) break; if (sp > XB_SPIN_CAP) { atomicAdd(&bar[XB_TMO], 1u); break; } }
    }
    nloc = mine > 0u ? mine : 1u; nx = cnt > 0u ? cnt : 1u;
}

__device__ __forceinline__ void xcd_barrier(const XcdBarrier& b) {
    asm volatile("s_waitcnt vmcnt(0)" ::: "memory");
    __syncthreads();
    if (threadIdx.x == 0) {
        unsigned* bar = b.bar;
        __builtin_amdgcn_s_waitcnt(0);
        unsigned nloc = b.st[0], nx = b.st[1];
        if (nloc == 0u) { xcd_barrier_complete(bar, b.x, nloc, nx); b.st[0] = nloc; b.st[1] = nx; }
        const unsigned old = xb_add(&bar[XB_XSUB(b.x)], 1u);
        const unsigned gen = old / nloc;
        if (old + 1u == (gen + 1u) * nloc) {
            __builtin_amdgcn_fence(__ATOMIC_RELEASE, "agent");
            asm volatile("s_waitcnt vmcnt(0)" ::: "memory");
            const unsigned og = xb_add(&bar[XB_TOP], 1u);
            const unsigned tg = og / nx;
            if (og + 1u == (tg + 1u) * nx) xb_add(&bar[XB_TOPGEN], 1u);
            else XB_SPIN(xb_ld(&bar[XB_TOPGEN]) == tg, bar);
            __builtin_amdgcn_fence(__ATOMIC_ACQUIRE, "agent");
            xb_add(&bar[XB_XGEN(b.x)], 1u);
            asm volatile("s_waitcnt vmcnt(0)" ::: "memory");
        } else {
            XB_SPIN(xb_ld(&bar[XB_XGEN(b.x)]) == gen, bar);
            __builtin_amdgcn_fence(__ATOMIC_ACQUIRE, "agent");
            asm volatile("s_waitcnt vmcnt(0)" ::: "memory");
        }
    }
    __syncthreads();
}


constexpr int N_PHASES = 15;
#ifndef MK_CGSYNC
#define MK_CGSYNC 0
#endif
#ifndef PH_EN
#define PH_EN 0xfffff
#endif
#define EN(n) ((PH_EN >> (n)) & 1)
#ifndef REP_MASK
#define REP_MASK 0
#endif
#define REPS(n) (1 + ((REP_MASK >> (n)) & 1))
__global__ void __launch_bounds__(512, 2) mk_fwd(Params p, int ph_lo, int ph_hi) {
    extern __shared__ __attribute__((aligned(16))) unsigned char smem[];
    cg::grid_group grid = cg::this_grid();
    volatile PG8_LAS unsigned* xst = (volatile PG8_LAS unsigned*)((PG8_LAS unsigned char*)smem + LDS_MISC);
    if (threadIdx.x < 2) xst[threadIdx.x] = 0u;
    __syncthreads();
    XcdBarrier xbar = xcd_barrier_post((unsigned*)(p.ws + WS_BAR), xst);
#define IN(k) (EN(k) && ph_lo <= (k) && (k) < ph_hi)
#define SEAM(k) do { if ((k) + 1 < ph_hi) { if (MK_CGSYNC) grid.sync(); else xcd_barrier(xbar); } } while (0)
#define LDSP ((PG8_LAS unsigned char*)smem)
#define SSB ((float*)(p.ws + WS_SS))
#define WSB(off) ((bf16*)(p.ws + (off)))
    if (ph_hi > 1000) grid.sync();
    if (IN(0)) { for (int rep = 0; rep < REPS(0); ++rep) phase_prologue(p, smem); SEAM(0); }
    if (IN(1)) for (int rep = 0; rep < REPS(1); ++rep) {
        pg8::Gemm g{WSB(WS_XB), WSB(WS_W_INREC), T_TOK, NPROJ, DM}; pg8::StaticOrder S; S.init(T_TOK, NPROJ, gridDim.x, blockIdx.x);
        pg8::EpiScaleBf16 E{WSB(WS_BIG), NPROJ, SSB};
        pg8::gemm_phase<pg8::EpiScaleBf16, pg8::StaticOrder, true, true>(LDSP, g, S, E);
        {
            const int G = gridDim.x, rem = (64 * 14) % G;
            if (rem == 0) convert_items(p, smem, CONV_SPLIT, CONV_SPLIT2, blockIdx.x, G);
            else if ((int)blockIdx.x >= rem) convert_items(p, smem, CONV_SPLIT, CONV_SPLIT2, blockIdx.x - rem, G - rem);
        }
        SEAM(1);
    }
    if (IN(2)) { for (int rep = 0; rep < REPS(2); ++rep) { phase_conv(p); phase_hgrn_a(p, smem); } SEAM(2); }
    if (IN(3)) { for (int rep = 0; rep < REPS(3); ++rep) phase_hgrn_b(p); SEAM(3); }
    if (IN(4)) { for (int rep = 0; rep < REPS(4); ++rep) phase_hgrn_c(p, smem); SEAM(4); }
    if (IN(5)) {
        pg8::Gemm g{WSB(WS_MIX), WSB(WS_W_OUTREC), T_TOK, DM, DM}; pg8::StaticOrder S; S.init(T_TOK, DM, gridDim.x, blockIdx.x);
        pg8::EpiResid E{nullptr, WSB(WS_XB), WSB(WS_XB), SSB + 1 * T_TOK};
        pg8::gemm_phase<pg8::EpiResid, pg8::StaticOrder, true, true>(LDSP, g, S, E);
        SEAM(5);
    }
    if (IN(6)) for (int rep = 0; rep < REPS(6); ++rep) {
        pg8::Gemm g{WSB(WS_XB), WSB(WS_W_FFNIN0), T_TOK, 2 * DFF, DM}; pg8::StaticOrder S; S.init(T_TOK, 2 * DFF, gridDim.x, blockIdx.x);
        pg8::EpiSwiGLU E{WSB(WS_BIG), SSB + 1 * T_TOK};
        pg8::gemm_phase<pg8::EpiSwiGLU, pg8::StaticOrder, true, true>(LDSP, g, S, E);
        {
            const int G = gridDim.x, rem = (64 * 22) % G;
            if (rem == 0) convert_items(p, smem, CONV_SPLIT2, 1600, blockIdx.x, G);
            else if ((int)blockIdx.x >= rem) convert_items(p, smem, CONV_SPLIT2, 1600, blockIdx.x - rem, G - rem);
        }
        SEAM(6);
    }
    if (IN(7)) {
        pg8::Gemm g{WSB(WS_BIG), WSB(WS_W_FFNOUT0), T_TOK, DM, DFF}; pg8::StaticOrder S; S.init(T_TOK, DM, gridDim.x, blockIdx.x);
        pg8::EpiResid E{nullptr, WSB(WS_XB), WSB(WS_XB), SSB + 2 * T_TOK};
        pg8::gemm_phase<pg8::EpiResid, pg8::StaticOrder, true, true>(LDSP, g, S, E);
        SEAM(7);
    }
    if (IN(8)) {
        pg8::Gemm g{WSB(WS_XB), WSB(WS_W_QKV), T_TOK, 3 * DM, DM}; pg8::StaticOrder S; S.init(T_TOK, 3 * DM, gridDim.x, blockIdx.x);
        pg8::EpiQKV E{WSB(WS_BIG), SSB + 2 * T_TOK, (const float*)(p.ws + WS_ROPE)};
        pg8::gemm_phase<pg8::EpiQKV, pg8::StaticOrder, true, true>(LDSP, g, S, E);
        SEAM(8);
    }
    if (IN(9)) { for (int rep = 0; rep < REPS(9); ++rep) phase_attn3(p, smem); SEAM(9); }
    if (IN(10)) { phase_attn_merge(p); SEAM(10); }
    if (IN(11)) {
        pg8::Gemm g{WSB(WS_MIX), WSB(WS_W_O), T_TOK, DM, DM}; pg8::StaticOrder S; S.init(T_TOK, DM, gridDim.x, blockIdx.x);
        pg8::EpiResid E{nullptr, WSB(WS_XB), WSB(WS_XB), SSB + 3 * T_TOK};
        pg8::gemm_phase<pg8::EpiResid, pg8::StaticOrder, true, true>(LDSP, g, S, E);
        SEAM(11);
    }
    if (IN(12)) {
        pg8::Gemm g{WSB(WS_XB), WSB(WS_W_FFNIN1), T_TOK, 2 * DFF, DM}; pg8::StaticOrder S; S.init(T_TOK, 2 * DFF, gridDim.x, blockIdx.x);
        pg8::EpiSwiGLU E{WSB(WS_BIG), SSB + 3 * T_TOK};
        pg8::gemm_phase<pg8::EpiSwiGLU, pg8::StaticOrder, true, true>(LDSP, g, S, E);
        SEAM(12);
    }
    if (IN(13)) {
        pg8::Gemm g{WSB(WS_BIG), WSB(WS_W_FFNOUT1), T_TOK, DM, DFF}; pg8::StaticOrder S; S.init(T_TOK, DM, gridDim.x, blockIdx.x);
        pg8::EpiResid E{nullptr, WSB(WS_XB), WSB(WS_XB), SSB + 4 * T_TOK};
        pg8::gemm_phase<pg8::EpiResid, pg8::StaticOrder, true, true>(LDSP, g, S, E);
        SEAM(13);
    }
    if (IN(14)) { phase_final(p); }
}

extern "C" void kernel_launch(void* const* d_in, const int* in_sizes, int n_in, void* d_out, int out_size, void* d_ws, size_t ws_size, hipStream_t stream) {
    static int grid = 0;
    if (grid == 0) {
        if (n_in != 13 || in_sizes[0] != T_TOK * DM || out_size != T_TOK * DM || ws_size < WS_END) {
            fprintf(stderr, "kernel_launch: unexpected shapes (n_in %d, in0 %d, out %d, ws %zu)\n", n_in, n_in > 0 ? in_sizes[0] : -1, out_size, ws_size); grid = -1; return;
        }
        int dev = 0, cus = 0, per_cu = 0;
        hipGetDevice(&dev); hipDeviceGetAttribute(&cus, hipDeviceAttributeMultiprocessorCount, dev);
        if (hipFuncSetAttribute((const void*)mk_fwd, hipFuncAttributeMaxDynamicSharedMemorySize, LDS_BYTES) != hipSuccess) { fprintf(stderr, "kernel_launch: hipFuncSetAttribute failed\n"); grid = -1; return; }
        if (hipOccupancyMaxActiveBlocksPerMultiprocessor(&per_cu, (const void*)mk_fwd, 512, LDS_BYTES) != hipSuccess || per_cu < 1) { fprintf(stderr, "kernel_launch: occupancy query says %d\n", per_cu); per_cu = 1; (void)hipGetLastError(); }
        grid = cus * 1;
        if (per_cu < 1) grid = -1;
    }
    if (grid < 0) return;
    Params p{};
    p.x = (const float*)d_in[0]; p.mix_norm = (const float*)d_in[1]; p.ffn_norm = (const float*)d_in[2]; p.w_in_rec = (const float*)d_in[3]; p.conv_w = (const float*)d_in[4];
    p.hgrn_lb = (const float*)d_in[5]; p.hgrn_norm = (const float*)d_in[6]; p.w_out_rec = (const float*)d_in[7]; p.w_qkv = (const float*)d_in[8]; p.w_o = (const float*)d_in[9];
    p.w_ffn_in = (const float*)d_in[10]; p.w_ffn_out = (const float*)d_in[11]; p.final_norm = (const float*)d_in[12];
    p.out = (float*)d_out; p.ws = (unsigned char*)d_ws;
    if (hipMemsetAsync((char*)d_ws + WS_BAR, 0, 16384, stream) != hipSuccess) { fprintf(stderr, "kernel_launch: memset failed\n"); return; }
#if MK_SPLIT
    for (int ph = 0; ph < N_PHASES; ++ph) {
        hipLaunchKernelGGL(mk_fwd, dim3(grid), dim3(512), LDS_BYTES, stream, p, ph, ph + 1);
    }
#else
    int lo = 0, hi = N_PHASES;
    void* args[] = {&p, &lo, &hi};
    hipError_t e = hipLaunchCooperativeKernel((const void*)mk_fwd, dim3(grid), dim3(512), args, LDS_BYTES, stream);
    if (e != hipSuccess) fprintf(stderr, "kernel_launch: cooperative launch failed: %s (grid %d)\n", hipGetErrorString(e), grid);
#endif
}
```

```cpp
#include <hip/hip_runtime.h>
#include <hip/hip_cooperative_groups.h>
#include <cstdio>
#include <cstdint>
namespace cg = cooperative_groups;
#ifndef MK_SPLIT
#define MK_SPLIT 0
#endif
namespace pg8 {
#define PG8_LAS __attribute__((address_space(3)))
typedef unsigned short bf16_t;
typedef short bf16x8 __attribute__((ext_vector_type(8)));
typedef float f32x4 __attribute__((ext_vector_type(4)));
typedef unsigned u32x4 __attribute__((ext_vector_type(4)));
constexpr int BM = 256, BK = 64, HALF = 128, HTB = HALF * BK * 2  , STAGE_BYTES = 8 * HTB, NXCD = 8, WGM = 8;

__host__ __device__ __forceinline__ int lds_byte(int r, int c) { const int st = (r >> 4) * 2 + (c >> 5), rr = r & 15, cc = c & 31, ob = rr * 64 + cc * 2; return st * 1024 + (ob ^ (((ob >> 9) & 1) << 5)); }
__host__ __device__ __forceinline__ void stage_rc(int b, int& R, int& C) { const int st = b / 1024, sb = b % 1024, swz = sb ^ (((sb >> 9) & 1) << 5); R = (st >> 1) * 16 + swz / 64; C = (st & 1) * 32 + (swz % 64) / 2; }
__host__ __device__ __forceinline__ int perm32(int rho) { const int n = rho >> 4, i = rho & 15; return 8 * (i >> 2) + 4 * n + (i & 3); }

struct Unit { int pm, pn; };
struct Gemm { const bf16_t* A; const bf16_t* Bt; int M, N, K; };

struct StaticOrder {
    int nM, nN, nwg, G, c;
    __host__ __device__ void init(int M, int N, int G_, int c_) { nM = M / BM; nN = N / BM; nwg = nM * nN; G = G_; c = c_; }
    __host__ __device__ bool next(int i, Unit& u) const {
        const long L = (long)i * G + c; if (L >= nwg) return false;
        int wgid = (int)L; { const int q = nwg / NXCD, r = nwg % NXCD, xcd = wgid % NXCD, off = wgid / NXCD; wgid = (xcd < r ? xcd * (q + 1) : r * (q + 1) + (xcd - r) * q) + off; }
        const int nig = WGM * nN, gid = wgid / nig, fm = gid * WGM, gsz = (nM - fm) < WGM ? (nM - fm) : WGM;
        u.pm = fm + ((wgid % nig) % gsz); u.pn = (wgid % nig) / gsz; return true;
    }
    __device__ __forceinline__ void a_ready(const Unit&) const {}
    __device__ __forceinline__ void done(const Unit&) const {}
};
typedef float cvt_f32x2_t __attribute__((ext_vector_type(2))); typedef __bf16 cvt_bf16x2_t __attribute__((ext_vector_type(2)));
__device__ __forceinline__ unsigned cvt_pk_bf16(float lo, float hi) { cvt_f32x2_t v = {lo, hi}; cvt_bf16x2_t b = __builtin_convertvector(v, cvt_bf16x2_t); return __builtin_bit_cast(unsigned, b); }
typedef float f32x2 __attribute__((ext_vector_type(2)));

template <class Epi, class Sched, bool ALIGN_EPI = false, bool SP2 = false>
__device__ __forceinline__ void gemm_phase(PG8_LAS unsigned char* lds, const Gemm g, const Sched& S, const Epi& E) {
    const int tid = threadIdx.x, wid = __builtin_amdgcn_readfirstlane(tid >> 6), lane = tid & 63, wr = wid >> 2, wc = wid & 3, fr = lane & 15, fq = lane >> 4;
    const int K = g.K, nt = K / BK;
    unsigned voffA[2], voffB[2];
#pragma unroll
    for (int i = 0; i < 2; ++i) { int R, C; stage_rc(tid * 16 + i * 8192, R, C); const int Rb = Epi::PERM ? ((R & ~31) + perm32(R & 31)) : R;
        voffA[i] = (unsigned)(R * K + C) * 2u; voffB[i] = (unsigned)(Rb * K + C) * 2u; }
    const size_t kstep = (size_t)(BK * 2);
    const size_t hstep = (size_t)HALF * K * 2;
    const size_t tstep = 2 * hstep;
    const unsigned ldsw = (unsigned)wid * 1024u;
    const int aoff = lds_byte(wr * 64 + fr, fq * 8), boff = lds_byte(wc * 32 + fr, fq * 8);
#define PG8_SA(b, h) (((b) * 2 + (h)) * HTB)
#define PG8_SB(b, h) ((4 + (b) * 2 + (h)) * HTB)
#define PG8_STAGE(bufoff, gbase, voff) do { _Pragma("unroll") for (int _i = 0; _i < 2; ++_i) \
        __builtin_amdgcn_global_load_lds((const unsigned*)((const char*)(gbase) + (voff)[_i]), (PG8_LAS unsigned*)(lds + (bufoff) + ldsw + _i * 8192), 16, 0, 0); } while (0)
#define PG8_LDA(dst, b, h) do { _Pragma("unroll") for (int m = 0; m < 4; ++m) _Pragma("unroll") for (int k = 0; k < 2; ++k) dst[m][k] = *(const PG8_LAS bf16x8*)(lds + PG8_SA(b, h) + aoff + m * 2048 + k * 1024); } while (0)
#define PG8_LDB(dst, b, h) do { _Pragma("unroll") for (int n = 0; n < 2; ++n) _Pragma("unroll") for (int k = 0; k < 2; ++k) dst[n][k] = *(const PG8_LAS bf16x8*)(lds + PG8_SB(b, h) + boff + n * 2048 + k * 1024); } while (0)
#define PG8_MMA(ai, bj, At, Bt) do { __builtin_amdgcn_s_setprio(1); _Pragma("unroll") for (int m = 0; m < 4; ++m) _Pragma("unroll") for (int n = 0; n < 2; ++n) _Pragma("unroll") for (int k = 0; k < 2; ++k) \
        acc[ai][bj][m][n] = __builtin_amdgcn_mfma_f32_16x16x32_bf16(Bt[n][k], At[m][k], acc[ai][bj][m][n], 0, 0, 0); __builtin_amdgcn_s_setprio(0); } while (0)
#define PG8_WAIT_V(n) asm volatile("s_waitcnt vmcnt(" #n ")" ::: "memory")
#define PG8_WAIT_L(n) asm volatile("s_waitcnt lgkmcnt(" #n ")" ::: "memory")
#define PG8_BAR __builtin_amdgcn_s_barrier()
#define PG8_SCHED __builtin_amdgcn_sched_barrier(0)
    Unit cur, nxt; int ui = 0;
    if (!S.next(0, cur)) return;
    f32x4 acc[2][2][4][2];
#pragma unroll
    for (int a = 0; a < 2; ++a)
#pragma unroll
        for (int b = 0; b < 2; ++b)
#pragma unroll
            for (int m = 0; m < 4; ++m)
#pragma unroll
                for (int n = 0; n < 2; ++n) acc[a][b][m][n] = (f32x4){0.f, 0.f, 0.f, 0.f};
    bf16x8 At[4][2], B0[2][2], B1[2][2];
    const char* cA = (const char*)g.A + (size_t)cur.pm * tstep; const char* cB = (const char*)g.Bt + (size_t)cur.pn * tstep;
    S.a_ready(cur);
    typename Epi::Pre pre; E.prefetch(pre, cur, wr, fr); __builtin_amdgcn_sched_barrier(0);
    if constexpr (SP2) {
        PG8_STAGE(PG8_SB(0, 0), cB, voffB); PG8_STAGE(PG8_SB(0, 1), cB + hstep, voffB); PG8_STAGE(PG8_SA(0, 0), cA, voffA); PG8_STAGE(PG8_SA(0, 1), cA + hstep, voffA);
        if (wr == 1) PG8_BAR;
        PG8_WAIT_V(2); PG8_BAR;
        PG8_STAGE(PG8_SB(1, 0), cB + kstep, voffB); PG8_STAGE(PG8_SA(1, 0), cA + kstep, voffA); PG8_STAGE(PG8_SB(1, 1), cB + hstep + kstep, voffB);
        PG8_WAIT_V(6); PG8_BAR;
    } else {
        PG8_STAGE(PG8_SB(0, 0), cB, voffB); PG8_STAGE(PG8_SA(0, 0), cA, voffA); PG8_STAGE(PG8_SB(0, 1), cB + hstep, voffB); PG8_STAGE(PG8_SA(0, 1), cA + hstep, voffA);
        if (wr == 1) PG8_BAR;
        PG8_WAIT_V(4); PG8_BAR;
        PG8_STAGE(PG8_SB(1, 0), cB + kstep, voffB); PG8_STAGE(PG8_SA(1, 0), cA + kstep, voffA); PG8_STAGE(PG8_SB(1, 1), cB + hstep + kstep, voffB);
        PG8_WAIT_V(6); PG8_BAR;
    }
    for (;;) {
        const bool has_next = S.next(ui + 1, nxt);
        const char* nA = has_next ? (const char*)g.A + (size_t)nxt.pm * tstep : cA; const char* nB = has_next ? (const char*)g.Bt + (size_t)nxt.pn * tstep : cB;
        for (int t = 0; t < nt; t += 2) {
            const bool last = (t == nt - 2);
            const char* a1 = cA + (size_t)(t + 1) * kstep;
            const char* a2 = last ? nA : cA + (size_t)(t + 2) * kstep; const char* b2 = last ? nB : cB + (size_t)(t + 2) * kstep;
            const char* a3 = a2 + kstep; const char* b3 = b2 + kstep;
            if (last && has_next) S.a_ready(nxt);
            if constexpr (SP2) {
            PG8_LDB(B0, 0, 0); PG8_LDB(B1, 0, 1); PG8_SCHED; PG8_LDA(At, 0, 0); PG8_STAGE(PG8_SA(1, 1), a1 + hstep, voffA);
            PG8_WAIT_V(8); PG8_WAIT_L(0); PG8_BAR; PG8_MMA(0, 0, At, B0); PG8_MMA(0, 1, At, B1); PG8_BAR; PG8_SCHED;
            PG8_LDA(At, 0, 1); PG8_STAGE(PG8_SB(0, 0), b2, voffB); PG8_STAGE(PG8_SB(0, 1), b2 + hstep, voffB); PG8_STAGE(PG8_SA(0, 0), a2, voffA);
            PG8_WAIT_V(8); PG8_WAIT_L(0); PG8_BAR; PG8_MMA(1, 0, At, B0); PG8_MMA(1, 1, At, B1); PG8_BAR; PG8_SCHED;
            PG8_LDB(B0, 1, 0); PG8_LDB(B1, 1, 1); PG8_SCHED; PG8_LDA(At, 1, 0); PG8_STAGE(PG8_SA(0, 1), a2 + hstep, voffA);
            PG8_WAIT_V(8); PG8_WAIT_L(0); PG8_BAR; PG8_MMA(0, 0, At, B0); PG8_MMA(0, 1, At, B1); PG8_BAR; PG8_SCHED;
            PG8_LDA(At, 1, 1); PG8_STAGE(PG8_SB(1, 0), b3, voffB); PG8_STAGE(PG8_SB(1, 1), b3 + hstep, voffB); PG8_STAGE(PG8_SA(1, 0), a3, voffA);
            PG8_WAIT_V(8); PG8_WAIT_L(0); PG8_BAR; PG8_MMA(1, 0, At, B0); PG8_MMA(1, 1, At, B1); PG8_BAR; PG8_SCHED;
            } else {
            PG8_LDB(B0, 0, 0); PG8_SCHED; PG8_LDA(At, 0, 0); PG8_STAGE(PG8_SA(1, 1), a1 + hstep, voffA);
            PG8_WAIT_L(8); PG8_BAR; PG8_WAIT_L(0); PG8_MMA(0, 0, At, B0); PG8_BAR; PG8_SCHED;
            PG8_LDB(B1, 0, 1); PG8_STAGE(PG8_SB(0, 0), b2, voffB);
            PG8_BAR; PG8_WAIT_L(0); PG8_MMA(0, 1, At, B1); PG8_BAR;
            PG8_LDA(At, 0, 1); PG8_STAGE(PG8_SA(0, 0), a2, voffA);
            PG8_BAR; PG8_WAIT_L(0); PG8_MMA(1, 0, At, B0); PG8_BAR; PG8_SCHED;
            PG8_STAGE(PG8_SB(0, 1), b2 + hstep, voffB);
            PG8_WAIT_V(6); PG8_BAR; PG8_MMA(1, 1, At, B1); PG8_BAR;
            PG8_LDB(B0, 1, 0); PG8_SCHED; PG8_LDA(At, 1, 0); PG8_STAGE(PG8_SA(0, 1), a2 + hstep, voffA);
            PG8_WAIT_L(8); PG8_BAR; PG8_WAIT_L(0); PG8_MMA(0, 0, At, B0); PG8_BAR; PG8_SCHED;
            PG8_LDB(B1, 1, 1); PG8_STAGE(PG8_SB(1, 0), b3, voffB);
            PG8_BAR; PG8_WAIT_L(0); PG8_MMA(0, 1, At, B1); PG8_BAR;
            PG8_LDA(At, 1, 1); PG8_STAGE(PG8_SA(1, 0), a3, voffA);
            PG8_BAR; PG8_WAIT_L(0); PG8_MMA(1, 0, At, B0); PG8_BAR; PG8_SCHED;
            PG8_STAGE(PG8_SB(1, 1), b3 + hstep, voffB);
            PG8_WAIT_V(6); PG8_BAR; PG8_MMA(1, 1, At, B1); PG8_BAR;
            }
        }
        if constexpr (ALIGN_EPI) { if (wr == 0) PG8_BAR; }
        if constexpr (!Epi::AFTER_DRAIN) { E(acc, cur, wr, wc, fr, fq, pre); S.done(cur); }
        if (!has_next) break;
#pragma unroll
        for (int a = 0; a < 2; ++a)
#pragma unroll
            for (int b = 0; b < 2; ++b)
#pragma unroll
                for (int m = 0; m < 4; ++m)
#pragma unroll
                    for (int n = 0; n < 2; ++n) acc[a][b][m][n] = (f32x4){0.f, 0.f, 0.f, 0.f};
        cur = nxt; cA = nA; cB = nB; ++ui;
        E.prefetch(pre, cur, wr, fr); __builtin_amdgcn_sched_barrier(0);
        if constexpr (ALIGN_EPI) { if (wr == 1) PG8_BAR; }
    }
    PG8_WAIT_V(0);
    if constexpr (!ALIGN_EPI) { if (wr == 0) PG8_BAR; }
    PG8_BAR;
    if constexpr (Epi::AFTER_DRAIN) { E.fused(acc, cur, wr, wc, fr, fq, lds, wid, lane); S.done(cur); }
#undef PG8_SA
#undef PG8_SB
#undef PG8_STAGE
#undef PG8_LDA
#undef PG8_LDB
#undef PG8_MMA
#undef PG8_WAIT_V
#undef PG8_WAIT_L
#undef PG8_BAR
#undef PG8_SCHED
}
}

constexpr int T_TOK = 16384, SEQ = 2048, DM = 1024, DFF = 2816, NPROJ = 3584;
constexpr float RMS_EPS = 1e-6f;
constexpr size_t MiB = 1u << 20;
constexpr size_t WS_SS = 0;
constexpr size_t WS_DEC = 512 * 1024;
constexpr size_t WS_ROPE = 1 * MiB;
constexpr size_t WS_W_INREC = 2 * MiB, WS_W_OUTREC = 9 * MiB, WS_W_QKV = 11 * MiB, WS_W_O = 17 * MiB;
constexpr size_t WS_W_FFNIN0 = 19 * MiB, WS_W_FFNIN1 = 30 * MiB, WS_W_FFNOUT0 = 41 * MiB, WS_W_FFNOUT1 = 46 * MiB + 512 * 1024;
constexpr size_t WS_XB = 52 * MiB;
constexpr size_t WS_MIX = 84 * MiB;
constexpr size_t WS_BIG = 116 * MiB;
constexpr size_t WS_OB2 = 212 * MiB;
constexpr size_t WS_LSE = 244 * MiB;
constexpr size_t WS_END = 247 * MiB;
constexpr int LDS_BYTES = 147456 + 256;
constexpr int LDS_MISC = 147456;
constexpr size_t WS_BAR = 384 * 1024;

typedef unsigned short bf16;
using pg8::bf16x8; using pg8::f32x4; using pg8::u32x4;
typedef float f32x16 __attribute__((ext_vector_type(16)));
typedef unsigned u32x2 __attribute__((ext_vector_type(2)));

struct Params {
    const float *x, *mix_norm, *ffn_norm, *w_in_rec, *conv_w, *hgrn_lb, *hgrn_norm, *w_out_rec, *w_qkv, *w_o, *w_ffn_in, *w_ffn_out, *final_norm;
    float* out; unsigned char* ws;
};

typedef float f32x2_t __attribute__((ext_vector_type(2)));
typedef __bf16 bf16x2_t __attribute__((ext_vector_type(2)));
__device__ __forceinline__ unsigned pk2(float lo, float hi) { f32x2_t v = {lo, hi}; bf16x2_t b = __builtin_convertvector(v, bf16x2_t); return __builtin_bit_cast(unsigned, b); }
__device__ __forceinline__ unsigned f2bf(float f) { return pk2(f, 0.f) & 0xffffu; }
__device__ __forceinline__ float bf2f(unsigned short b) { return __builtin_bit_cast(float, (unsigned)b << 16); }
__device__ __forceinline__ float bflo(unsigned u) { return __builtin_bit_cast(float, u << 16); }
__device__ __forceinline__ float bfhi(unsigned u) { return __builtin_bit_cast(float, u & 0xffff0000u); }
__device__ __forceinline__ float wave_sum(float v) {
#pragma unroll
    for (int o = 1; o < 64; o <<= 1) v += __shfl_xor(v, o);
    return v;
}
__device__ __forceinline__ float xor32_max(float x) { const unsigned xi = __builtin_bit_cast(unsigned, x); auto r = __builtin_amdgcn_permlane32_swap(xi, xi, false, false); return fmaxf(__builtin_bit_cast(float, (unsigned)r[0]), __builtin_bit_cast(float, (unsigned)r[1])); }
__device__ __forceinline__ float xor32_sum(float x) { const unsigned xi = __builtin_bit_cast(unsigned, x); auto r = __builtin_amdgcn_permlane32_swap(xi, xi, false, false); return __builtin_bit_cast(float, (unsigned)r[0]) + __builtin_bit_cast(float, (unsigned)r[1]); }
__device__ __forceinline__ float sigmoidf_(float z) { return __builtin_amdgcn_rcpf(1.f + __expf(-z)); }

namespace pg8 {
#ifndef MK_WT_STORES
#define MK_WT_STORES 1
#endif
__device__ __forceinline__ void st16(void* p, u32x4 v) {
#if MK_WT_STORES
    asm volatile("global_store_dwordx4 %0, %1, off sc1\n\ts_nop 1" :: "v"(p), "v"(v) : "memory");
#else
    *(u32x4*)p = v;
#endif
}
struct EpiScaleBf16 {
    static constexpr bool PERM = true, AFTER_DRAIN = false;
    bf16_t* O; int ldc; const float* ss;
    struct Pre { float ssv[2][4]; };
    __device__ __forceinline__ void prefetch(Pre& pre, const Unit& u, int wr, int fr) const {
#pragma unroll
        for (int ai = 0; ai < 2; ++ai)
#pragma unroll
            for (int m = 0; m < 4; ++m) pre.ssv[ai][m] = ss[u.pm * BM + wr * 64 + fr + ai * HALF + m * 16];
    }
    __device__ __forceinline__ void operator()(const f32x4 (&acc)[2][2][4][2], const Unit& u, int wr, int wc, int fr, int fq, const Pre& pre) const {
        const int row0 = u.pm * BM + wr * 64 + fr, col0 = u.pn * BM + wc * 32 + 8 * fq;
#pragma unroll
        for (int ai = 0; ai < 2; ++ai)
#pragma unroll
            for (int m = 0; m < 4; ++m) {
                const int row = row0 + ai * HALF + m * 16;
                const float r = rsqrtf(pre.ssv[ai][m] * (1.f / 1024.f) + 1e-6f);
                bf16_t* rowp = O + (size_t)row * ldc + col0;
#pragma unroll
                for (int bj = 0; bj < 2; ++bj) {
                    const f32x4 v0 = acc[ai][bj][m][0] * r, v1 = acc[ai][bj][m][1] * r;
                    u32x4 w; w.x = cvt_pk_bf16(v0[0], v0[1]); w.y = cvt_pk_bf16(v0[2], v0[3]); w.z = cvt_pk_bf16(v1[0], v1[1]); w.w = cvt_pk_bf16(v1[2], v1[3]);
                    st16(rowp + bj * HALF, w);
                }
            }
    }
};
struct EpiSwiGLU {
    static constexpr bool PERM = true, AFTER_DRAIN = false;
    bf16_t* H; const float* ss;
    struct Pre { float ssv[2][4]; };
    __device__ __forceinline__ void prefetch(Pre& pre, const Unit& u, int wr, int fr) const {
#pragma unroll
        for (int ai = 0; ai < 2; ++ai)
#pragma unroll
            for (int m = 0; m < 4; ++m) pre.ssv[ai][m] = ss[u.pm * BM + wr * 64 + fr + ai * HALF + m * 16];
    }
    __device__ __forceinline__ void operator()(const f32x4 (&acc)[2][2][4][2], const Unit& u, int wr, int wc, int fr, int fq, const Pre& pre) const {
        const int row0 = u.pm * BM + wr * 64 + fr, col0 = u.pn * HALF + wc * 32 + 8 * fq;
#pragma unroll
        for (int ai = 0; ai < 2; ++ai)
#pragma unroll
            for (int m = 0; m < 4; ++m) {
                const int row = row0 + ai * HALF + m * 16;
                const float r = rsqrtf(pre.ssv[ai][m] * (1.f / 1024.f) + 1e-6f);
                float o[8];
#pragma unroll
                for (int n = 0; n < 2; ++n)
#pragma unroll
                    for (int j = 0; j < 4; ++j) {
                        const float g = acc[ai][0][m][n][j] * r, up = acc[ai][1][m][n][j] * r;
                        o[4 * n + j] = g * up * __builtin_amdgcn_rcpf(1.f + __expf(-g));
                    }
                u32x4 w; w.x = cvt_pk_bf16(o[0], o[1]); w.y = cvt_pk_bf16(o[2], o[3]); w.z = cvt_pk_bf16(o[4], o[5]); w.w = cvt_pk_bf16(o[6], o[7]);
                st16(H + (size_t)row * 2816 + col0, w);
            }
    }
};
struct EpiQKV {
    static constexpr bool PERM = true, AFTER_DRAIN = false;
    bf16_t* QKV; const float* ss; const float* rope;
    struct Pre { float ssv[2][4]; };
    __device__ __forceinline__ void prefetch(Pre& pre, const Unit& u, int wr, int fr) const {
#pragma unroll
        for (int ai = 0; ai < 2; ++ai)
#pragma unroll
            for (int m = 0; m < 4; ++m) pre.ssv[ai][m] = ss[u.pm * BM + wr * 64 + fr + ai * HALF + m * 16];
    }
    __device__ __forceinline__ void operator()(const f32x4 (&acc)[2][2][4][2], const Unit& u, int wr, int wc, int fr, int fq, const Pre& pre) const {
        const int row0 = u.pm * BM + wr * 64 + fr;
        const int t = u.pn >> 2, head = 4 * (u.pn & 3) + wc;
        bf16_t* base = QKV + (size_t)t * ((size_t)16384 * 1024) + (size_t)head * (2048 * 64) + 8 * fq;
        const float qs = (t == 0) ? 0.125f : 1.f;
#pragma unroll
        for (int ai = 0; ai < 2; ++ai)
#pragma unroll
            for (int m = 0; m < 4; ++m) {
                const int row = row0 + ai * HALF + m * 16;
                const float r = rsqrtf(pre.ssv[ai][m] * (1.f / 1024.f) + 1e-6f) * qs;
                float y1[8], y2[8];
                if (t < 2) {
                    const float* cs = rope + (size_t)(row & 2047) * 64 + 8 * fq;
                    const f32x4 c0 = *(const f32x4*)(cs), c1 = *(const f32x4*)(cs + 4), s0 = *(const f32x4*)(cs + 32), s1 = *(const f32x4*)(cs + 36);
#pragma unroll
                    for (int j = 0; j < 4; ++j) {
                        const float a0 = acc[ai][0][m][0][j] * r, b0 = acc[ai][1][m][0][j] * r, a1 = acc[ai][0][m][1][j] * r, b1 = acc[ai][1][m][1][j] * r;
                        y1[j] = a0 * c0[j] - b0 * s0[j]; y2[j] = a0 * s0[j] + b0 * c0[j];
                        y1[4 + j] = a1 * c1[j] - b1 * s1[j]; y2[4 + j] = a1 * s1[j] + b1 * c1[j];
                    }
                } else {
#pragma unroll
                    for (int j = 0; j < 4; ++j) { y1[j] = acc[ai][0][m][0][j] * r; y2[j] = acc[ai][1][m][0][j] * r; y1[4 + j] = acc[ai][0][m][1][j] * r; y2[4 + j] = acc[ai][1][m][1][j] * r; }
                }
                u32x4 w1, w2;
                w1.x = cvt_pk_bf16(y1[0], y1[1]); w1.y = cvt_pk_bf16(y1[2], y1[3]); w1.z = cvt_pk_bf16(y1[4], y1[5]); w1.w = cvt_pk_bf16(y1[6], y1[7]);
                w2.x = cvt_pk_bf16(y2[0], y2[1]); w2.y = cvt_pk_bf16(y2[2], y2[3]); w2.z = cvt_pk_bf16(y2[4], y2[5]); w2.w = cvt_pk_bf16(y2[6], y2[7]);
                bf16_t* rp = base + (size_t)(row >> 11) * (16 * 2048 * 64) + (size_t)(row & 2047) * 64;
                st16(rp, w1); st16(rp + 32, w2);
            }
    }
};
struct EpiResid {
    static constexpr bool PERM = true, AFTER_DRAIN = false;
    const float* x32; const bf16_t* xb; bf16_t* XB; float* ssout;
    struct Pre {};
    __device__ __forceinline__ void prefetch(Pre&, const Unit&, int, int) const {}
    __device__ __forceinline__ void operator()(const f32x4 (&acc)[2][2][4][2], const Unit& u, int wr, int wc, int fr, int fq, const Pre& pre) const {
        const int row0 = u.pm * BM + wr * 64 + fr, col0 = u.pn * BM + wc * 32 + 8 * fq;
        float srow[2][4];
#pragma unroll
        for (int ai = 0; ai < 2; ++ai) {
            f32x4 xr[4][2][2];
            if (x32) {
#pragma unroll
                for (int m = 0; m < 4; ++m)
#pragma unroll
                    for (int bj = 0; bj < 2; ++bj) { const float* px = x32 + (size_t)(row0 + ai * HALF + m * 16) * 1024 + col0 + bj * HALF; xr[m][bj][0] = *(const f32x4*)(px); xr[m][bj][1] = *(const f32x4*)(px + 4); }
            } else {
                u32x4 xv[4][2];
#pragma unroll
                for (int m = 0; m < 4; ++m)
#pragma unroll
                    for (int bj = 0; bj < 2; ++bj) xv[m][bj] = *(const u32x4*)(xb + (size_t)(row0 + ai * HALF + m * 16) * 1024 + col0 + bj * HALF);
#pragma unroll
                for (int m = 0; m < 4; ++m)
#pragma unroll
                    for (int bj = 0; bj < 2; ++bj) {
                        const u32x4 v = xv[m][bj];
                        xr[m][bj][0] = (f32x4){__builtin_bit_cast(float, v.x << 16), __builtin_bit_cast(float, v.x & 0xffff0000u), __builtin_bit_cast(float, v.y << 16), __builtin_bit_cast(float, v.y & 0xffff0000u)};
                        xr[m][bj][1] = (f32x4){__builtin_bit_cast(float, v.z << 16), __builtin_bit_cast(float, v.z & 0xffff0000u), __builtin_bit_cast(float, v.w << 16), __builtin_bit_cast(float, v.w & 0xffff0000u)};
                    }
            }
#pragma unroll
            for (int m = 0; m < 4; ++m) {
                const size_t off = (size_t)(row0 + ai * HALF + m * 16) * 1024 + col0;
                float s = 0.f;
#pragma unroll
                for (int bj = 0; bj < 2; ++bj) {
                    const f32x4 v0 = acc[ai][bj][m][0] + xr[m][bj][0], v1 = acc[ai][bj][m][1] + xr[m][bj][1];
                    u32x4 w; w.x = cvt_pk_bf16(v0[0], v0[1]); w.y = cvt_pk_bf16(v0[2], v0[3]); w.z = cvt_pk_bf16(v1[0], v1[1]); w.w = cvt_pk_bf16(v1[2], v1[3]);
                    st16(XB + off + bj * HALF, w);
                    const float r0 = __builtin_bit_cast(float, w.x << 16), r1 = __builtin_bit_cast(float, w.x & 0xffff0000u), r2 = __builtin_bit_cast(float, w.y << 16), r3 = __builtin_bit_cast(float, w.y & 0xffff0000u);
                    const float r4 = __builtin_bit_cast(float, w.z << 16), r5 = __builtin_bit_cast(float, w.z & 0xffff0000u), r6 = __builtin_bit_cast(float, w.w << 16), r7 = __builtin_bit_cast(float, w.w & 0xffff0000u);
                    s += (r0 * r0 + r1 * r1) + (r2 * r2 + r3 * r3) + (r4 * r4 + r5 * r5) + (r6 * r6 + r7 * r7);
                }
                srow[ai][m] = s;
            }
        }
#pragma unroll
        for (int ai = 0; ai < 2; ++ai)
#pragma unroll
            for (int m = 0; m < 4; ++m) srow[ai][m] += __shfl_xor(srow[ai][m], 16);
#pragma unroll
        for (int ai = 0; ai < 2; ++ai)
#pragma unroll
            for (int m = 0; m < 4; ++m) srow[ai][m] += __shfl_xor(srow[ai][m], 32);
        if (fq == 0) {
#pragma unroll
            for (int ai = 0; ai < 2; ++ai)
#pragma unroll
                for (int m = 0; m < 4; ++m) atomicAdd(ssout + row0 + ai * HALF + m * 16, srow[ai][m]);
        }
    }
};
}

__device__ __forceinline__ int src_col(int kind, int n) {
    if (kind == 0) return n;
    const int pn = n >> 8, bj = (n >> 7) & 1, c = n & 127;
    if (kind == 1) return bj * 2816 + 128 * pn + c;
    const int t = pn >> 2, head = 4 * (pn & 3) + (c >> 5), i = c & 31;
    return t * 1024 + head * 64 + bj * 32 + i;
}
__device__ __forceinline__ void convert_tile(const float* __restrict__ W, bf16* __restrict__ Bt, int K, int N, const float* __restrict__ gain, int kind, int tile, float* Tl) {
    const int ntn = N >> 8; const int kt = tile / ntn, nt = tile - kt * ntn; const int k0 = kt * 64, n0 = nt * 256;
    const int tid = threadIdx.x;
    {
        f32x4 v[8];
        const int n4 = (tid & 63) * 4; const int sc = src_col(kind, n0 + n4);
#pragma unroll
        for (int i = 0; i < 8; ++i) { const int kk = i * 8 + (tid >> 6); v[i] = *(const f32x4*)(W + (size_t)(k0 + kk) * N + sc); }
        if (gain) {
#pragma unroll
            for (int i = 0; i < 8; ++i) v[i] = v[i] * gain[k0 + i * 8 + (tid >> 6)];
        }
#pragma unroll
        for (int i = 0; i < 8; ++i) { const int kk = i * 8 + (tid >> 6); *(f32x4*)(Tl + kk * 260 + n4) = v[i]; }
    }
    __syncthreads();
    {
        const int n = tid & 255, chalf = tid >> 8;
#pragma unroll
        for (int i = 0; i < 4; ++i) {
            const int c = 2 * i + chalf; const float* sp = Tl + (8 * c) * 260 + n;
            u32x4 o; o.x = pg8::cvt_pk_bf16(sp[0], sp[260]); o.y = pg8::cvt_pk_bf16(sp[520], sp[780]); o.z = pg8::cvt_pk_bf16(sp[1040], sp[1300]); o.w = pg8::cvt_pk_bf16(sp[1560], sp[1820]);
            *(u32x4*)(Bt + (size_t)(n0 + n) * K + k0 + 8 * c) = o;
        }
    }
    __syncthreads();
}

__device__ __forceinline__ void convert_items(const Params& p, unsigned char* smem, int lo, int hi, int first, int stride) {
    float* Tl = (float*)smem;
    for (int item = lo + first; item < hi; item += stride) {
        int t = item; const float* W; bf16* Bt; int K, N, kind; const float* gain;
        if (t < 224) { W = p.w_in_rec; Bt = (bf16*)(p.ws + WS_W_INREC); K = 1024; N = 3584; kind = 0; gain = p.mix_norm; }
        else if ((t -= 224) < 64) { W = p.w_out_rec; Bt = (bf16*)(p.ws + WS_W_OUTREC); K = 1024; N = 1024; kind = 0; gain = nullptr; }
        else if ((t -= 64) < 352) { W = p.w_ffn_in; Bt = (bf16*)(p.ws + WS_W_FFNIN0); K = 1024; N = 5632; kind = 1; gain = p.ffn_norm; }
        else if ((t -= 352) < 176) { W = p.w_ffn_out; Bt = (bf16*)(p.ws + WS_W_FFNOUT0); K = 2816; N = 1024; kind = 0; gain = nullptr; }
        else if ((t -= 176) < 192) { W = p.w_qkv; Bt = (bf16*)(p.ws + WS_W_QKV); K = 1024; N = 3072; kind = 2; gain = p.mix_norm + 1024; }
        else if ((t -= 192) < 64) { W = p.w_o; Bt = (bf16*)(p.ws + WS_W_O); K = 1024; N = 1024; kind = 0; gain = nullptr; }
        else if ((t -= 64) < 352) { W = p.w_ffn_in + (size_t)1024 * 5632; Bt = (bf16*)(p.ws + WS_W_FFNIN1); K = 1024; N = 5632; kind = 1; gain = p.ffn_norm + 1024; }
        else { t -= 352; W = p.w_ffn_out + (size_t)2816 * 1024; Bt = (bf16*)(p.ws + WS_W_FFNOUT1); K = 2816; N = 1024; kind = 0; gain = nullptr; }
        convert_tile(W, Bt, K, N, gain, kind, t, Tl);
    }
}
#ifndef CONV_SPLIT2
#define CONV_SPLIT2 816
#endif
#ifndef CONV_SPLIT
#define CONV_SPLIT 224
#endif

__device__ __forceinline__ void phase_prologue(const Params& p, unsigned char* smem) {
    const int tid = threadIdx.x, lane = tid & 63, wave = tid >> 6;
    convert_items(p, smem, 0, CONV_SPLIT, blockIdx.x, gridDim.x);
    {
        float* ss = (float*)(p.ws + WS_SS); bf16* XB = (bf16*)(p.ws + WS_XB);
        for (int row = blockIdx.x * 8 + wave; row < T_TOK; row += gridDim.x * 8) {
            const f32x4* xr = (const f32x4*)(p.x + (size_t)row * 1024) + lane;
            f32x4 v[4]; float s = 0.f;
#pragma unroll
            for (int j = 0; j < 4; ++j) { v[j] = xr[64 * j]; s += (v[j][0] * v[j][0] + v[j][1] * v[j][1]) + (v[j][2] * v[j][2] + v[j][3] * v[j][3]); }
            s = wave_sum(s);
            u32x2* o = (u32x2*)(XB + (size_t)row * 1024) + lane;
#pragma unroll
            for (int j = 0; j < 4; ++j) { u32x2 w; w.x = pk2(v[j][0], v[j][1]); w.y = pk2(v[j][2], v[j][3]); o[64 * j] = w; }
            if (lane == 0) ss[row] = s;
        }
        for (int i = blockIdx.x * 512 + tid; i < 4 * T_TOK; i += gridDim.x * 512) ss[T_TOK + i] = 0.f;
    }
    {
        float* rope = (float*)(p.ws + WS_ROPE);
        for (int i = blockIdx.x * 512 + tid; i < SEQ * 32; i += gridDim.x * 512) {
            const int pos = i >> 5, f = i & 31;
            const float freq = exp2f(-(float)f * (13.287712379549449f / 32.f));
            const float ang = (float)pos * freq;
            const double a = (double)ang; const double kq = rint(a * 0.15915494309189535); const float r = (float)(a - kq * 6.283185307179586);
            rope[pos * 64 + f] = __cosf(r); rope[pos * 64 + 32 + f] = __sinf(r);
        }
    }
}

__device__ __forceinline__ float hgrn_lb_of(const Params& p, int ch) {
    const float a = p.hgrn_lb[ch], b = p.hgrn_lb[512 + ch], c = p.hgrn_lb[1024 + ch];
    const float m = fmaxf(a, fmaxf(b, c)); const float ea = __expf(a - m), eb = __expf(b - m), ec = __expf(c - m);
    return eb * __builtin_amdgcn_rcpf(ea + eb + ec);
}

__device__ __forceinline__ void phase_conv(const Params& p) {
    const bf16* PROJ = (const bf16*)(p.ws + WS_BIG); bf16* MIX = (bf16*)(p.ws + WS_MIX);
    const int tid = threadIdx.x;
    for (int task = blockIdx.x * 512 + tid; task < T_TOK * 64; task += gridDim.x * 512) {
        const int tok = task >> 6, c8 = (task & 63) * 8; const int pos = tok & (SEQ - 1);
        const bf16* row = PROJ + (size_t)tok * NPROJ + c8;
        const u32x4 bg = *(const u32x4*)(row);
        float y[8];
#pragma unroll
        for (int e = 0; e < 8; ++e) y[e] = 0.f;
#pragma unroll
        for (int j = 0; j < 3; ++j) {
            const int back = 2 - j;
            if (pos >= back) {
                const bf16* rj = row - (size_t)back * NPROJ;
                const u32x4 cgv = *(const u32x4*)(rj + 512), vcv = *(const u32x4*)(rj + 1024);
                const f32x4 w0 = *(const f32x4*)(p.conv_w + j * 512 + c8), w1 = *(const f32x4*)(p.conv_w + j * 512 + c8 + 4);
#pragma unroll
                for (int q = 0; q < 4; ++q) {
                    const float wl = (q < 2) ? w0[2 * q] : w1[2 * q - 4], wh = (q < 2) ? w0[2 * q + 1] : w1[2 * q - 3];
                    y[2 * q] += wl * bflo(cgv[q]) * bflo(vcv[q]);
                    y[2 * q + 1] += wh * bfhi(cgv[q]) * bfhi(vcv[q]);
                }
            }
        }
        u32x4 o;
#pragma unroll
        for (int q = 0; q < 4; ++q) o[q] = pk2(y[2 * q] * bflo(bg[q]), y[2 * q + 1] * bfhi(bg[q]));
        *(u32x4*)(MIX + (size_t)tok * 1024 + c8) = o;
    }
}

#define MFMA16(a, b, c) __builtin_amdgcn_mfma_f32_16x16x32_bf16((a), (b), (c), 0, 0, 0)
#define MFMA32(a, b, c) __builtin_amdgcn_mfma_f32_32x32x16_bf16((a), (b), (c), 0, 0, 0)

__device__ __forceinline__ void phase_hgrn_a(const Params& p, unsigned char* smem) {
    const bf16* PROJ = (const bf16*)(p.ws + WS_BIG); bf16* UT = (bf16*)p.out; float* DEC = (float*)(p.ws + WS_DEC);
    bf16* KgT = (bf16*)smem;
    bf16* VT = KgT + 128 * 72;
    float* part = (float*)(smem + 2 * 128 * 72 * 2);
    const int tid = threadIdx.x, lane = tid & 63, wave = tid >> 6, fr = lane & 15, fq = lane >> 4;
    const int k = tid & 127, qd = tid >> 7;
    for (int item = blockIdx.x; item < 1024; item += gridDim.x) {
        const int bh = item >> 5, c = item & 31, b = bh >> 2, h = bh & 3;
        const int t0 = b * SEQ + c * 64;
        const float lb = hgrn_lb_of(p, h * 128 + k);
        const bf16* zp = PROJ + (size_t)(t0 + 16 * qd) * NPROJ + 2048 + h * 128 + k;
        float G[16], kk[16], vv[16];
        float run = 0.f;
#pragma unroll
        for (int i = 0; i < 16; ++i) {
            const float z = bf2f(zp[(size_t)i * NPROJ]); const float iv = bf2f(zp[(size_t)i * NPROJ + 512]);
            const float sg = sigmoidf_(z); const float f = lb + (1.f - lb) * sg;
            run += __logf(f); G[i] = run; kk[i] = 1.f - f; vv[i] = iv * sigmoidf_(iv);
        }
        part[qd * 128 + k] = run;
        __syncthreads();
        float off = 0.f, tot = 0.f;
#pragma unroll
        for (int q = 0; q < 4; ++q) { const float pv = part[q * 128 + k]; tot += pv; if (q < qd) off += pv; }
        {
            unsigned kw[8], vw[8];
#pragma unroll
            for (int i = 0; i < 8; ++i) {
                const float g0 = G[2 * i] + off, g1 = G[2 * i + 1] + off;
                kw[i] = pk2(kk[2 * i] * __expf(tot - g0), kk[2 * i + 1] * __expf(tot - g1));
                vw[i] = pk2(vv[2 * i], vv[2 * i + 1]);
            }
            u32x4* kd = (u32x4*)(KgT + k * 72 + 16 * qd); u32x4* vd = (u32x4*)(VT + k * 72 + 16 * qd);
            kd[0] = (u32x4){kw[0], kw[1], kw[2], kw[3]}; kd[1] = (u32x4){kw[4], kw[5], kw[6], kw[7]};
            vd[0] = (u32x4){vw[0], vw[1], vw[2], vw[3]}; vd[1] = (u32x4){vw[4], vw[5], vw[6], vw[7]};
        }
        if (qd == 0) DEC[item * 128 + k] = __expf(tot);
        __syncthreads();
        {
            const int mt = wave;
            bf16x8 a[2];
#pragma unroll
            for (int ks = 0; ks < 2; ++ks) a[ks] = *(const bf16x8*)(KgT + (16 * mt + fr) * 72 + 32 * ks + 8 * fq);
            bf16* ub = UT + (size_t)item * 16384 + 16 * mt + 4 * fq;
#pragma unroll
            for (int nt = 0; nt < 8; ++nt) {
                f32x4 acc = {0.f, 0.f, 0.f, 0.f};
#pragma unroll
                for (int ks = 0; ks < 2; ++ks) { const bf16x8 bb = *(const bf16x8*)(VT + (16 * nt + fr) * 72 + 32 * ks + 8 * fq); acc = MFMA16(a[ks], bb, acc); }
                { u32x2 w; w.x = pk2(acc[0], acc[1]); w.y = pk2(acc[2], acc[3]); *(u32x2*)(ub + (size_t)(16 * nt + fr) * 128) = w; }
            }
        }
        __syncthreads();
    }
}

__device__ __forceinline__ void phase_hgrn_b(const Params& p) {
    const bf16* UT = (const bf16*)p.out; const float* DEC = (const float*)(p.ws + WS_DEC); bf16* SP = (bf16*)p.out + (size_t)T_TOK * 1024;
    for (int e4 = blockIdx.x * 512 + threadIdx.x; e4 < 32 * 4096; e4 += gridDim.x * 512) {
        const int bh = e4 >> 12, r = e4 & 4095, k4 = (r & 31) * 4;
        f32x4 S = {0.f, 0.f, 0.f, 0.f};
#pragma unroll 8
        for (int c = 0; c < 32; ++c) {
            const int item = bh * 32 + c;
            u32x2 w; w.x = pk2(S[0], S[1]); w.y = pk2(S[2], S[3]);
            *(u32x2*)(SP + (size_t)item * 16384 + r * 4) = w;
            const f32x4 d = *(const f32x4*)(DEC + item * 128 + k4); const u32x2 uw = *(const u32x2*)(UT + (size_t)item * 16384 + r * 4); const f32x4 u = {bflo(uw.x), bfhi(uw.x), bflo(uw.y), bfhi(uw.y)};
            S = d * S + u;
        }
    }
}

__device__ __forceinline__ void phase_hgrn_c(const Params& p, unsigned char* smem) {
    const bf16* PROJ = (const bf16*)(p.ws + WS_BIG); const bf16* SP = (const bf16*)p.out + (size_t)T_TOK * 1024; bf16* MIX = (bf16*)(p.ws + WS_MIX);
    bf16* Am = (bf16*)smem;
    bf16* Bm = Am + 64 * 136;
    bf16* Qg = Bm + 64 * 136;
    bf16* VT = Qg + 64 * 136;
    bf16* P = VT + 128 * 72;
    float* part = (float*)(smem + 3 * 17408 + 18432 + 9216);
    float* rowss = part + 512;
    const int tid = threadIdx.x, lane = tid & 63, wave = tid >> 6, fr = lane & 15, fq = lane >> 4;
    const int k = tid & 127, qd = tid >> 7;
    typedef unsigned short us2 __attribute__((ext_vector_type(2)));
    us2 zi[16], qq[8];
    if ((int)blockIdx.x < 1024) {
        const int item = blockIdx.x; const int bh = item >> 5, c = item & 31, b = bh >> 2, h = bh & 3;
        const bf16* zp = PROJ + (size_t)(b * SEQ + c * 64 + 16 * qd) * NPROJ + 2048 + h * 128 + k;
#pragma unroll
        for (int i = 0; i < 16; ++i) { zi[i].x = zp[(size_t)i * NPROJ]; zi[i].y = zp[(size_t)i * NPROJ + 512]; if (i & 1) qq[i >> 1].y = zp[(size_t)i * NPROJ - 512]; else qq[i >> 1].x = zp[(size_t)i * NPROJ - 512]; }
    }
    for (int item = blockIdx.x; item < 1024; item += gridDim.x) {
        const int bh = item >> 5, c = item & 31, b = bh >> 2, h = bh & 3;
        const int t0 = b * SEQ + c * 64;
        const float lb = hgrn_lb_of(p, h * 128 + k);
        float G[16], kk[16], vv[16], qv[16];
        float run = 0.f;
#pragma unroll
        for (int i = 0; i < 16; ++i) {
            const float z = bf2f(zi[i].x); const float iv = bf2f(zi[i].y); qv[i] = bf2f((i & 1) ? qq[i >> 1].y : qq[i >> 1].x);
            const float sg = sigmoidf_(z); const float f = lb + (1.f - lb) * sg;
            run += __logf(f); G[i] = run; kk[i] = 1.f - f; vv[i] = iv * sigmoidf_(iv);
        }
        part[qd * 128 + k] = run;
#pragma unroll
        for (int i = 0; i < 16; ++i) {
            const int t = 16 * qd + i;
            Am[t * 136 + k] = (bf16)f2bf(qv[i] * __expf(G[i])); Bm[t * 136 + k] = (bf16)f2bf(kk[i] * __expf(run - G[i]));
        }
        for (int i = tid; i < 2304; i += 512) ((unsigned*)P)[i] = 0u;
        __syncthreads();
        float off = 0.f;
#pragma unroll
        for (int q = 0; q < 4; ++q) { const float pv = part[q * 128 + k]; if (q < qd) off += pv; }
        {
            unsigned vw[8];
#pragma unroll
            for (int i = 0; i < 16; ++i) {
                const float g = G[i] + off; const int t = 16 * qd + i;
                Qg[t * 136 + k] = (bf16)f2bf(qv[i] * __expf(g));
            }
#pragma unroll
            for (int i = 0; i < 8; ++i) vw[i] = pk2(vv[2 * i], vv[2 * i + 1]);
            u32x4* vd = (u32x4*)(VT + k * 72 + 16 * qd);
            vd[0] = (u32x4){vw[0], vw[1], vw[2], vw[3]}; vd[1] = (u32x4){vw[4], vw[5], vw[6], vw[7]};
        }
        __syncthreads();
        {
            const int nitem = item + gridDim.x;
            if (nitem < 1024) {
                const int nbh = nitem >> 5, nc = nitem & 31, nb = nbh >> 2, nh = nbh & 3;
                const bf16* zp = PROJ + (size_t)(nb * SEQ + nc * 64 + 16 * qd) * NPROJ + 2048 + nh * 128 + k;
#pragma unroll
                for (int i = 0; i < 16; ++i) { zi[i].x = zp[(size_t)i * NPROJ]; zi[i].y = zp[(size_t)i * NPROJ + 512]; if (i & 1) qq[i >> 1].y = zp[(size_t)i * NPROJ - 512]; else qq[i >> 1].x = zp[(size_t)i * NPROJ - 512]; }
            }
        }
        const int tt = wave & 3, vh = wave >> 2;
        bf16x8 sbf[4][4]; unsigned short gg[4][4];
        {
            const bf16* spb = SP + (size_t)item * 16384;
#pragma unroll
            for (int nt = 0; nt < 4; ++nt) {
                const int v = 16 * (4 * vh + nt) + fr;
#pragma unroll
                for (int ks = 0; ks < 4; ++ks) sbf[nt][ks] = *(const bf16x8*)(spb + (size_t)v * 128 + 32 * ks + 8 * fq);
#pragma unroll
                for (int j = 0; j < 4; ++j) gg[nt][j] = PROJ[(size_t)(t0 + 16 * tt + 4 * fq + j) * NPROJ + 3072 + h * 128 + v];
            }
        }
        for (int sb = wave; sb < 10; sb += 8) {
            const int I = (sb >= 6) ? 3 : (sb >= 3) ? 2 : (sb >= 1) ? 1 : 0; const int J = sb - (I * (I + 1)) / 2;
            f32x4 acc = {0.f, 0.f, 0.f, 0.f};
#pragma unroll
            for (int ks = 0; ks < 4; ++ks) {
                const int kb = 32 * ks + 8 * fq;
                const bf16x8 av = *(const bf16x8*)(Am + (16 * I + fr) * 136 + kb);
                u32x4 bw = *(const u32x4*)(Bm + (16 * J + fr) * 136 + kb);
                if (J != I - 1) {
                    f32x4 e0, e1;
                    if (J == I) { e0 = -*(const f32x4*)(part + I * 128 + kb); e1 = -*(const f32x4*)(part + I * 128 + kb + 4); }
                    else {
                        e0 = *(const f32x4*)(part + (J + 1) * 128 + kb); e1 = *(const f32x4*)(part + (J + 1) * 128 + kb + 4);
                        if (I - J == 3) { e0 += *(const f32x4*)(part + (J + 2) * 128 + kb); e1 += *(const f32x4*)(part + (J + 2) * 128 + kb + 4); }
                    }
#pragma unroll
                    for (int e = 0; e < 4; ++e) {
                        const float xl = (e < 2) ? e0[2 * e] : e1[2 * e - 4], xh = (e < 2) ? e0[2 * e + 1] : e1[2 * e - 3];
                        bw[e] = pk2(bflo(bw[e]) * __expf(fminf(xl, 80.f)), bfhi(bw[e]) * __expf(fminf(xh, 80.f)));
                    }
                }
                acc = MFMA16(av, __builtin_bit_cast(bf16x8, bw), acc);
            }
#pragma unroll
            for (int j = 0; j < 4; ++j) { const int t = 16 * I + 4 * fq + j, s = 16 * J + fr; P[t * 72 + s] = (bf16)f2bf((s <= t) ? acc[j] : 0.f); }
        }
        __syncthreads();
        f32x4 o[4];
        {
            bf16x8 aq[4], ap[2];
#pragma unroll
            for (int ks = 0; ks < 4; ++ks) aq[ks] = *(const bf16x8*)(Qg + (16 * tt + fr) * 136 + 32 * ks + 8 * fq);
#pragma unroll
            for (int ks = 0; ks < 2; ++ks) ap[ks] = *(const bf16x8*)(P + (16 * tt + fr) * 72 + 32 * ks + 8 * fq);
#pragma unroll
            for (int nt = 0; nt < 4; ++nt) {
                const int v = 16 * (4 * vh + nt) + fr;
                f32x4 acc = {0.f, 0.f, 0.f, 0.f};
#pragma unroll
                for (int ks = 0; ks < 4; ++ks) acc = MFMA16(aq[ks], sbf[nt][ks], acc);
#pragma unroll
                for (int ks = 0; ks < 2; ++ks) { const bf16x8 bb = *(const bf16x8*)(VT + v * 72 + 32 * ks + 8 * fq); acc = MFMA16(ap[ks], bb, acc); }
                o[nt] = acc;
            }
        }
        {
            float s4[4];
#pragma unroll
            for (int j = 0; j < 4; ++j) {
                float s = o[0][j] * o[0][j] + o[1][j] * o[1][j] + o[2][j] * o[2][j] + o[3][j] * o[3][j];
                s += __shfl_xor(s, 1); s += __shfl_xor(s, 2); s += __shfl_xor(s, 4); s += __shfl_xor(s, 8);
                s4[j] = s;
            }
            if (fr == 0) {
#pragma unroll
                for (int j = 0; j < 4; ++j) rowss[(16 * tt + 4 * fq + j) * 2 + vh] = s4[j];
            }
        }
        __syncthreads();
#pragma unroll
        for (int j = 0; j < 4; ++j) {
            const int t = 16 * tt + 4 * fq + j;
            const float rs = rsqrtf((rowss[t * 2] + rowss[t * 2 + 1]) * (1.f / 128.f) + RMS_EPS);
#pragma unroll
            for (int nt = 0; nt < 4; ++nt) {
                const int v = 16 * (4 * vh + nt) + fr;
                const float g = bf2f(gg[nt][j]);
                const float val = o[nt][j] * rs * p.hgrn_norm[v] * (g * sigmoidf_(g));
                MIX[(size_t)(t0 + t) * 1024 + 512 + h * 128 + v] = (bf16)f2bf(val);
            }
        }
        __syncthreads();
    }
}

__device__ __forceinline__ int crow(int reg, int hi) { return (reg & 3) + 8 * (reg >> 2) + 4 * hi; }
constexpr float LOG2E = 1.4426950408889634f;

typedef short v4i16_t __attribute__((ext_vector_type(4)));
__device__ __forceinline__ u32x2 vtr_read(const unsigned char* pl) {
    return __builtin_bit_cast(u32x2, __builtin_amdgcn_ds_read_tr16_b64_v4i16((PG8_LAS v4i16_t*)pl));
}

#define ATT3_ISSUE_LOADS(BH, D, R, N) do { _Pragma("unroll") for (int i = 0; i < 8; ++i) { \
        const int chunk = i * 256 + gt, row = chunk >> 3, ch = chunk & 7; \
        const int kidx = 128 * ((N) - 1) + row; \
        kv[i] = (u32x4){0u, 0u, 0u, 0u}; vv[i] = (u32x4){0u, 0u, 0u, 0u}; \
        if (kidx >= 0) { const size_t off = ((size_t)(BH) * 2048 + kidx * (D) + (R)) * 64 + ch * 8; kv[i] = *(const u32x4*)(K + off); vv[i] = *(const u32x4*)(V + off); } } } while (0)
__device__ __forceinline__ void att3_job(int gp, int grp, int& bh, int& br, int& d, int& r, int& n) {
    bh = gp / 24; const int job = 2 * (gp - bh * 24) + grp;
    if (job < 16) { br = 0; d = 1; r = 0; n = job; }
    else if (job < 32) { br = 1; d = 4; r = (job - 16) >> 2; n = (job - 16) & 3; }
    else { br = 2; d = 16; r = job - 32; n = 0; }
}
template <int FIRST> __device__ __forceinline__ void att3_tiles(const unsigned char* kbase, const unsigned char* vbase, const bf16x8 (&qf)[4], int c, int hi,
                                                                float& mrun, float& lsum, f32x16& o0, f32x16& o1) {
    f32x16 scn;
#pragma unroll
    for (int j = 0; j < 16; ++j) scn[j] = 0.f;
    {
        const unsigned char* kp = kbase + (32 * FIRST) * 144;
#pragma unroll
        for (int ks = 0; ks < 4; ++ks) { const bf16x8 kf = *(const bf16x8*)(kp + 32 * ks); scn = MFMA32(kf, qf[ks], scn); }
    }
#pragma unroll
    for (int i = FIRST; i < 5; ++i) {
        f32x16 sc = scn;
        if (i + 1 < 5) {
#pragma unroll
            for (int j = 0; j < 16; ++j) scn[j] = 0.f;
            const unsigned char* kp = kbase + (32 * (i + 1)) * 144;
#pragma unroll
            for (int ks = 0; ks < 4; ++ks) { const bf16x8 kf = *(const bf16x8*)(kp + 32 * ks); scn = MFMA32(kf, qf[ks], scn); }
        }
        if (i == 0) {
#pragma unroll
            for (int j = 0; j < 16; ++j) sc[j] = (crow(j, hi) >= c) ? sc[j] : -1e30f;
        }
        if (i == 4) {
#pragma unroll
            for (int j = 0; j < 16; ++j) sc[j] = (crow(j, hi) <= c) ? sc[j] : -1e30f;
        }
        float mx = sc[0];
#pragma unroll
        for (int j = 1; j < 16; ++j) mx = fmaxf(mx, sc[j]);
        mx = xor32_max(mx);
        const float mnew = fmaxf(mrun, mx);
        const float alpha = __builtin_amdgcn_exp2f((mrun - mnew) * LOG2E);
        const float mL = mnew * LOG2E;
        float rs = 0.f;
#pragma unroll
        for (int j = 0; j < 16; ++j) { const float pj = __builtin_amdgcn_exp2f(sc[j] * LOG2E - mL); sc[j] = pj; rs += pj; }
        rs = xor32_sum(rs);
        lsum = lsum * alpha + rs; mrun = mnew;
#pragma unroll
        for (int j = 0; j < 16; ++j) { o0[j] *= alpha; o1[j] *= alpha; }
        const unsigned char* vp = vbase + (32 * i) * 144;
#pragma unroll
        for (int ks = 0; ks < 2; ++ks) {
            u32x4 w; w.x = pk2(sc[8 * ks], sc[8 * ks + 1]); w.y = pk2(sc[8 * ks + 2], sc[8 * ks + 3]);
            w.z = pk2(sc[8 * ks + 4], sc[8 * ks + 5]); w.w = pk2(sc[8 * ks + 6], sc[8 * ks + 7]);
            const bf16x8 pb = __builtin_bit_cast(bf16x8, w);
            const u32x2 a00 = vtr_read(vp + (16 * ks) * 144), a01 = vtr_read(vp + (16 * ks + 8) * 144);
            const u32x2 a10 = vtr_read(vp + (16 * ks) * 144 + 64), a11 = vtr_read(vp + (16 * ks + 8) * 144 + 64);
            const u32x4 A0 = {a00.x, a00.y, a01.x, a01.y}, A1 = {a10.x, a10.y, a11.x, a11.y};
            o0 = MFMA32(__builtin_bit_cast(bf16x8, A0), pb, o0);
            o1 = MFMA32(__builtin_bit_cast(bf16x8, A1), pb, o1);
        }
    }
}
__device__ __forceinline__ void phase_attn3(const Params& p, unsigned char* smem) {
    const bf16* Q = (const bf16*)(p.ws + WS_BIG); const bf16* K = Q + (size_t)T_TOK * 1024; const bf16* V = K + (size_t)T_TOK * 1024;
    float* LSE = (float*)(p.ws + WS_LSE);
    const int tid = threadIdx.x, lane = tid & 63, wave = tid >> 6, c = lane & 31, hi = lane >> 5;
    const int grp = wave >> 2, w4 = wave & 3, gt = tid & 255;
    unsigned char* Kl = smem + grp * 73728; unsigned char* Vl = Kl + 36864;
    const int trl = 144 * ((lane & 15) >> 2) + 32 * ((lane >> 4) & 1) + 8 * (lane & 3) + 144 * 4 * hi;
    const int G = gridDim.x; const bool xcdmap = (G == 256);
    const int xcd = blockIdx.x & 7, li = blockIdx.x >> 3;
    const int cnt = xcdmap ? 12 : ((3072 - (int)blockIdx.x + G - 1) / G);
#define ATT3_GP(i) (xcdmap ? (xcd * 384 + li + 32 * (i)) : ((int)blockIdx.x + G * (i)))
    if (cnt <= 0) return;
    u32x4 kv[8], vv[8];
    int bh, br, d, r, n;
    att3_job(ATT3_GP(0), grp, bh, br, d, r, n);
    ATT3_ISSUE_LOADS(bh, d, r, n);
    for (int it = 0; it < cnt; ++it) {
        const int qi0 = 128 * n + 32 * w4, rowoff = 128 - 128 * n;
#pragma unroll
        for (int i = 0; i < 8; ++i) {
            const int chunk = i * 256 + gt, row = chunk >> 3, ch = chunk & 7;
            *(u32x4*)(Kl + row * 144 + ch * 16) = kv[i]; *(u32x4*)(Vl + row * 144 + ch * 16) = vv[i];
        }
        const int b = bh >> 4, h = bh & 15;
        const int tok = b * SEQ + (qi0 + c) * d + r;
        bf16x8 qf[4];
        {
            const bf16* qp = Q + ((size_t)bh * 2048 + (qi0 + c) * d + r) * 64 + 8 * hi;
#pragma unroll
            for (int ks = 0; ks < 4; ++ks) qf[ks] = *(const bf16x8*)(qp + 16 * ks);
        }
        const int cbr = br;
        __syncthreads();
        if (it + 1 < cnt) { att3_job(ATT3_GP(it + 1), grp, bh, br, d, r, n); ATT3_ISSUE_LOADS(bh, d, r, n); }
        float mrun = -1e30f, lsum = 0.f;
        f32x16 o0, o1;
#pragma unroll
        for (int j = 0; j < 16; ++j) { o0[j] = 0.f; o1[j] = 0.f; }
        {
            const int first = (qi0 >= 128) ? 0 : (4 - (qi0 >> 5));
            const unsigned char* kbase = Kl + (rowoff + qi0 - 128 + c) * 144 + 16 * hi;
            const unsigned char* vbase = Vl + (rowoff + qi0 - 128) * 144 + trl;
            switch (first) {
            case 0: att3_tiles<0>(kbase, vbase, qf, c, hi, mrun, lsum, o0, o1); break;
            case 1: att3_tiles<1>(kbase, vbase, qf, c, hi, mrun, lsum, o0, o1); break;
            case 2: att3_tiles<2>(kbase, vbase, qf, c, hi, mrun, lsum, o0, o1); break;
            case 3: att3_tiles<3>(kbase, vbase, qf, c, hi, mrun, lsum, o0, o1); break;
            default: att3_tiles<4>(kbase, vbase, qf, c, hi, mrun, lsum, o0, o1); break;
            }
        }
        {
            bf16* OB = (cbr == 2) ? (bf16*)(p.ws + WS_OB2) : ((bf16*)p.out + (size_t)cbr * ((size_t)T_TOK * 1024));
            const float inv = __builtin_amdgcn_rcpf(lsum);
            bf16* op = OB + (size_t)tok * 1024 + h * 64 + 4 * hi;
#pragma unroll
            for (int q = 0; q < 4; ++q) {
                u32x2 w0, w1;
                w0.x = pg8::cvt_pk_bf16(o0[4 * q] * inv, o0[4 * q + 1] * inv); w0.y = pg8::cvt_pk_bf16(o0[4 * q + 2] * inv, o0[4 * q + 3] * inv);
                w1.x = pg8::cvt_pk_bf16(o1[4 * q] * inv, o1[4 * q + 1] * inv); w1.y = pg8::cvt_pk_bf16(o1[4 * q + 2] * inv, o1[4 * q + 3] * inv);
                *(u32x2*)(op + 8 * q) = w0; *(u32x2*)(op + 32 + 8 * q) = w1;
            }
            if (hi == 0) LSE[(size_t)cbr * (T_TOK * 16) + (size_t)tok * 16 + h] = mrun * LOG2E + __builtin_amdgcn_logf(lsum);
        }
        __syncthreads();
    }
}
__device__ __forceinline__ void phase_attn_merge(const Params& p) {
    const bf16* O0 = (const bf16*)p.out; const bf16* O1 = O0 + (size_t)T_TOK * 1024; const bf16* O2 = (const bf16*)(p.ws + WS_OB2);
    const float* LSE = (const float*)(p.ws + WS_LSE); bf16* ATT = (bf16*)(p.ws + WS_MIX);
    const bool xcdmap = (gridDim.x == 256);
    const int total = T_TOK * 128;
    const int nthr = xcdmap ? 32 * 512 : (int)gridDim.x * 512;
    const int first = xcdmap ? ((int)(blockIdx.x >> 3) * 512 + (int)threadIdx.x) : ((int)blockIdx.x * 512 + (int)threadIdx.x);
    const int base = xcdmap ? (int)(blockIdx.x & 7) * (SEQ * 128) : 0;
    const int lim = xcdmap ? SEQ * 128 : total;
    for (int j = first; j < lim; j += nthr) {
        const int i = base + j;
        const int tok = i >> 7, c8 = (i & 127) * 8, h = c8 >> 6;
        const float l0 = LSE[(size_t)tok * 16 + h], l1 = LSE[(size_t)T_TOK * 16 + (size_t)tok * 16 + h], l2 = LSE[(size_t)2 * T_TOK * 16 + (size_t)tok * 16 + h];
        const float M = fmaxf(l0, fmaxf(l1, l2));
        const float e0 = __builtin_amdgcn_exp2f(l0 - M), e1 = __builtin_amdgcn_exp2f(l1 - M), e2 = __builtin_amdgcn_exp2f(l2 - M);
        const float isum = __builtin_amdgcn_rcpf(e0 + e1 + e2); const float w0 = e0 * isum, w1 = e1 * isum, w2 = e2 * isum;
        const size_t off = (size_t)tok * 1024 + c8;
        const u32x4 a = *(const u32x4*)(O0 + off), bq = *(const u32x4*)(O1 + off), cc = *(const u32x4*)(O2 + off);
        u32x4 o;
#pragma unroll
        for (int q = 0; q < 4; ++q) o[q] = pk2(bflo(a[q]) * w0 + bflo(bq[q]) * w1 + bflo(cc[q]) * w2, bfhi(a[q]) * w0 + bfhi(bq[q]) * w1 + bfhi(cc[q]) * w2);
        *(u32x4*)(ATT + off) = o;
    }
}

__device__ __forceinline__ void phase_final(const Params& p) {
    const float* ss = (const float*)(p.ws + WS_SS) + 4 * T_TOK; const bf16* XB = (const bf16*)(p.ws + WS_XB);
    for (int i = blockIdx.x * 512 + threadIdx.x; i < T_TOK * 128; i += gridDim.x * 512) {
        const int row = i >> 7, c8 = (i & 127) * 8;
        const float r = rsqrtf(ss[row] * (1.f / 1024.f) + RMS_EPS);
        const u32x4 xv = *(const u32x4*)(XB + (size_t)row * 1024 + c8);
        const f32x4 g0 = *(const f32x4*)(p.final_norm + c8), g1 = *(const f32x4*)(p.final_norm + c8 + 4);
        f32x4 o0 = {bflo(xv.x), bfhi(xv.x), bflo(xv.y), bfhi(xv.y)}, o1 = {bflo(xv.z), bfhi(xv.z), bflo(xv.w), bfhi(xv.w)};
        *(f32x4*)(p.out + (size_t)row * 1024 + c8) = o0 * r * g0; *(f32x4*)(p.out + (size_t)row * 1024 + c8 + 4) = o1 * r * g1;
    }
}

#define XB_TMO      128
#define XB_XCNT(j)  (256  + 64 * (j))
#define XB_XSUB(j)  (1280 + 64 * (j))
#define XB_XGEN(j)  (2304 + 64 * (j))
#define XB_TOP      3328
#define XB_TOPGEN   3392
#define XCD_BAR_WORDS 3456
#define XB_SPIN_CAP (1u << 18)

__device__ __forceinline__ unsigned xb_ld(unsigned* p)              { return __hip_atomic_load(p, __ATOMIC_RELAXED, __HIP_MEMORY_SCOPE_AGENT); }
__device__ __forceinline__ unsigned xb_add(unsigned* p, unsigned v) { return __hip_atomic_fetch_add(p, v, __ATOMIC_RELAXED, __HIP_MEMORY_SCOPE_AGENT); }
__device__ __forceinline__ unsigned xb_xcc_id() { return (unsigned)__builtin_amdgcn_s_getreg((3 << 11) | 20) & 0xFu; }
#define XB_SPIN(cond, bar) do { unsigned _sp = 0; while (cond) { __builtin_amdgcn_s_sleep(1); \
    if ((++_sp & 255u) == 0u) { if (xb_ld(&(bar)[XB_TMO])) break; if (_sp > XB_SPIN_CAP) { atomicAdd(&(bar)[XB_TMO], 1u); break; } } } } while (0)

struct XcdBarrier {
    unsigned* bar; unsigned x;
    volatile PG8_LAS unsigned* st;
};

__device__ __forceinline__ XcdBarrier xcd_barrier_post(unsigned* bar, volatile PG8_LAS unsigned* st) {
    XcdBarrier b; b.bar = bar; b.x = xb_xcc_id(); b.st = st;
    if (threadIdx.x == 0) (void)xb_add(&bar[XB_XCNT(b.x)], 1u);
    return b;
}
__device__ __forceinline__ void xcd_barrier_complete(unsigned* bar, unsigned x, unsigned& nloc, unsigned& nx) {
    const unsigned G = gridDim.x * gridDim.y * gridDim.z;
    unsigned sum, cnt, mine, sp = 0u;
    for (;;) {
        sum = 0u; cnt = 0u; mine = 0u;
#pragma unroll
        for (unsigned j = 0; j < 16; ++j) { const unsigned c = xb_ld(&bar[XB_XCNT(j)]); sum += c; cnt += (c > 0u) ? 1u : 0u; mine = (j == x) ? c : mine; }
        if (sum == G) break;
        __builtin_amdgcn_s_sleep(1);
        if ((++sp & 255u) == 0u) { if (xb_ld(&bar[XB_TMO])) break; if (sp > XB_SPIN_CAP) { atomicAdd(&bar[XB_TMO], 1u); break; } }
    }
    nloc = mine > 0u ? mine : 1u; nx = cnt > 0u ? cnt : 1u;
}

__device__ __forceinline__ void xcd_barrier(const XcdBarrier& b) {
    asm volatile("s_waitcnt vmcnt(0)" ::: "memory");
    __syncthreads();
    if (threadIdx.x == 0) {
        unsigned* bar = b.bar;
        __builtin_amdgcn_s_waitcnt(0);
        unsigned nloc = b.st[0], nx = b.st[1];
        if (nloc == 0u) { xcd_barrier_complete(bar, b.x, nloc, nx); b.st[0] = nloc; b.st[1] = nx; }
        const unsigned old = xb_add(&bar[XB_XSUB(b.x)], 1u);
        const unsigned gen = old / nloc;
        if (old + 1u == (gen + 1u) * nloc) {
            __builtin_amdgcn_fence(__ATOMIC_RELEASE, "agent");
            asm volatile("s_waitcnt vmcnt(0)" ::: "memory");
            const unsigned og = xb_add(&bar[XB_TOP], 1u);
            const unsigned tg = og / nx;
            if (og + 1u == (tg + 1u) * nx) xb_add(&bar[XB_TOPGEN], 1u);
            else XB_SPIN(xb_ld(&bar[XB_TOPGEN]) == tg, bar);
            __builtin_amdgcn_fence(__ATOMIC_ACQUIRE, "agent");
            xb_add(&bar[XB_XGEN(b.x)], 1u);
            asm volatile("s_waitcnt vmcnt(0)" ::: "memory");
        } else {
            XB_SPIN(xb_ld(&bar[XB_XGEN(b.x)]) == gen, bar);
            __builtin_amdgcn_fence(__ATOMIC_ACQUIRE, "agent");
            asm volatile("s_waitcnt vmcnt(0)" ::: "memory");
        }
    }
    __syncthreads();
}


constexpr int N_PHASES = 15;
#ifndef MK_CGSYNC
#define MK_CGSYNC 0
#endif
#ifndef PH_EN
#define PH_EN 0xfffff
#endif
#define EN(n) ((PH_EN >> (n)) & 1)
#ifndef REP_MASK
#define REP_MASK 0
#endif
#define REPS(n) (1 + ((REP_MASK >> (n)) & 1))
__global__ void __launch_bounds__(512, 2) mk_fwd(Params p, int ph_lo, int ph_hi) {
    extern __shared__ __attribute__((aligned(16))) unsigned char smem[];
    cg::grid_group grid = cg::this_grid();
    volatile PG8_LAS unsigned* xst = (volatile PG8_LAS unsigned*)((PG8_LAS unsigned char*)smem + LDS_MISC);
    if (threadIdx.x < 2) xst[threadIdx.x] = 0u;
    __syncthreads();
    XcdBarrier xbar = xcd_barrier_post((unsigned*)(p.ws + WS_BAR), xst);
#define IN(k) (EN(k) && ph_lo <= (k) && (k) < ph_hi)
#define SEAM(k) do { if ((k) + 1 < ph_hi) { if (MK_CGSYNC) grid.sync(); else xcd_barrier(xbar); } } while (0)
#define LDSP ((PG8_LAS unsigned char*)smem)
#define SSB ((float*)(p.ws + WS_SS))
#define WSB(off) ((bf16*)(p.ws + (off)))
    if (ph_hi > 1000) grid.sync();
    if (IN(0)) { for (int rep = 0; rep < REPS(0); ++rep) phase_prologue(p, smem); SEAM(0); }
    if (IN(1)) for (int rep = 0; rep < REPS(1); ++rep) {
        pg8::Gemm g{WSB(WS_XB), WSB(WS_W_INREC), T_TOK, NPROJ, DM}; pg8::StaticOrder S; S.init(T_TOK, NPROJ, gridDim.x, blockIdx.x);
        pg8::EpiScaleBf16 E{WSB(WS_BIG), NPROJ, SSB};
        pg8::gemm_phase<pg8::EpiScaleBf16, pg8::StaticOrder, true, true>(LDSP, g, S, E);
        {
            const int G = gridDim.x, rem = (64 * 14) % G;
            if (rem == 0) convert_items(p, smem, CONV_SPLIT, CONV_SPLIT2, blockIdx.x, G);
            else if ((int)blockIdx.x >= rem) convert_items(p, smem, CONV_SPLIT, CONV_SPLIT2, blockIdx.x - rem, G - rem);
        }
        SEAM(1);
    }
    if (IN(2)) { for (int rep = 0; rep < REPS(2); ++rep) { phase_conv(p); phase_hgrn_a(p, smem); } SEAM(2); }
    if (IN(3)) { for (int rep = 0; rep < REPS(3); ++rep) phase_hgrn_b(p); SEAM(3); }
    if (IN(4)) { for (int rep = 0; rep < REPS(4); ++rep) phase_hgrn_c(p, smem); SEAM(4); }
    if (IN(5)) {
        pg8::Gemm g{WSB(WS_MIX), WSB(WS_W_OUTREC), T_TOK, DM, DM}; pg8::StaticOrder S; S.init(T_TOK, DM, gridDim.x, blockIdx.x);
        pg8::EpiResid E{nullptr, WSB(WS_XB), WSB(WS_XB), SSB + 1 * T_TOK};
        pg8::gemm_phase<pg8::EpiResid, pg8::StaticOrder, true, true>(LDSP, g, S, E);
        SEAM(5);
    }
    if (IN(6)) for (int rep = 0; rep < REPS(6); ++rep) {
        pg8::Gemm g{WSB(WS_XB), WSB(WS_W_FFNIN0), T_TOK, 2 * DFF, DM}; pg8::StaticOrder S; S.init(T_TOK, 2 * DFF, gridDim.x, blockIdx.x);
        pg8::EpiSwiGLU E{WSB(WS_BIG), SSB + 1 * T_TOK};
        pg8::gemm_phase<pg8::EpiSwiGLU, pg8::StaticOrder, true, true>(LDSP, g, S, E);
        {
            const int G = gridDim.x, rem = (64 * 22) % G;
            if (rem == 0) convert_items(p, smem, CONV_SPLIT2, 1600, blockIdx.x, G);
            else if ((int)blockIdx.x >= rem) convert_items(p, smem, CONV_SPLIT2, 1600, blockIdx.x - rem, G - rem);
        }
        SEAM(6);
    }
    if (IN(7)) {
        pg8::Gemm g{WSB(WS_BIG), WSB(WS_W_FFNOUT0), T_TOK, DM, DFF}; pg8::StaticOrder S; S.init(T_TOK, DM, gridDim.x, blockIdx.x);
        pg8::EpiResid E{nullptr, WSB(WS_XB), WSB(WS_XB), SSB + 2 * T_TOK};
        pg8::gemm_phase<pg8::EpiResid, pg8::StaticOrder, true, true>(LDSP, g, S, E);
        SEAM(7);
    }
    if (IN(8)) {
        pg8::Gemm g{WSB(WS_XB), WSB(WS_W_QKV), T_TOK, 3 * DM, DM}; pg8::StaticOrder S; S.init(T_TOK, 3 * DM, gridDim.x, blockIdx.x);
        pg8::EpiQKV E{WSB(WS_BIG), SSB + 2 * T_TOK, (const float*)(p.ws + WS_ROPE)};
        pg8::gemm_phase<pg8::EpiQKV, pg8::StaticOrder, true, true>(LDSP, g, S, E);
        SEAM(8);
    }
    if (IN(9)) { for (int rep = 0; rep < REPS(9); ++rep) phase_attn3(p, smem); SEAM(9); }
    if (IN(10)) { phase_attn_merge(p); SEAM(10); }
    if (IN(11)) {
        pg8::Gemm g{WSB(WS_MIX), WSB(WS_W_O), T_TOK, DM, DM}; pg8::StaticOrder S; S.init(T_TOK, DM, gridDim.x, blockIdx.x);
        pg8::EpiResid E{nullptr, WSB(WS_XB), WSB(WS_XB), SSB + 3 * T_TOK};
        pg8::gemm_phase<pg8::EpiResid, pg8::StaticOrder, true, true>(LDSP, g, S, E);
        SEAM(11);
    }
    if (IN(12)) {
        pg8::Gemm g{WSB(WS_XB), WSB(WS_W_FFNIN1), T_TOK, 2 * DFF, DM}; pg8::StaticOrder S; S.init(T_TOK, 2 * DFF, gridDim.x, blockIdx.x);
        pg8::EpiSwiGLU E{WSB(WS_BIG), SSB + 3 * T_TOK};
        pg8::gemm_phase<pg8::EpiSwiGLU, pg8::StaticOrder, true, true>(LDSP, g, S, E);
        SEAM(12);
    }
    if (IN(13)) {
        pg8::Gemm g{WSB(WS_BIG), WSB(WS_W_FFNOUT1), T_TOK, DM, DFF}; pg8::StaticOrder S; S.init(T_TOK, DM, gridDim.x, blockIdx.x);
        pg8::EpiResid E{nullptr, WSB(WS_XB), WSB(WS_XB), SSB + 4 * T_TOK};
        pg8::gemm_phase<pg8::EpiResid, pg8::StaticOrder, true, true>(LDSP, g, S, E);
        SEAM(13);
    }
    if (IN(14)) { phase_final(p); }
}

extern "C" void kernel_launch(void* const* d_in, const int* in_sizes, int n_in, void* d_out, int out_size, void* d_ws, size_t ws_size, hipStream_t stream) {
    static int grid = 0;
    if (grid == 0) {
        if (n_in != 13 || in_sizes[0] != T_TOK * DM || out_size != T_TOK * DM || ws_size < WS_END) {
            fprintf(stderr, "kernel_launch: unexpected shapes (n_in %d, in0 %d, out %d, ws %zu)\n", n_in, n_in > 0 ? in_sizes[0] : -1, out_size, ws_size); grid = -1; return;
        }
        int dev = 0, cus = 0, per_cu = 0;
        hipGetDevice(&dev); hipDeviceGetAttribute(&cus, hipDeviceAttributeMultiprocessorCount, dev);
        if (hipFuncSetAttribute((const void*)mk_fwd, hipFuncAttributeMaxDynamicSharedMemorySize, LDS_BYTES) != hipSuccess) { fprintf(stderr, "kernel_launch: hipFuncSetAttribute failed\n"); grid = -1; return; }
        if (hipOccupancyMaxActiveBlocksPerMultiprocessor(&per_cu, (const void*)mk_fwd, 512, LDS_BYTES) != hipSuccess || per_cu < 1) { fprintf(stderr, "kernel_launch: occupancy query says %d\n", per_cu); per_cu = 1; (void)hipGetLastError(); }
        grid = cus * 1;
        if (per_cu < 1) grid = -1;
    }
    if (grid < 0) return;
    Params p{};
    p.x = (const float*)d_in[0]; p.mix_norm = (const float*)d_in[1]; p.ffn_norm = (const float*)d_in[2]; p.w_in_rec = (const float*)d_in[3]; p.conv_w = (const float*)d_in[4];
    p.hgrn_lb = (const float*)d_in[5]; p.hgrn_norm = (const float*)d_in[6]; p.w_out_rec = (const float*)d_in[7]; p.w_qkv = (const float*)d_in[8]; p.w_o = (const float*)d_in[9];
    p.w_ffn_in = (const float*)d_in[10]; p.w_ffn_out = (const float*)d_in[11]; p.final_norm = (const float*)d_in[12];
    p.out = (float*)d_out; p.ws = (unsigned char*)d_ws;
    if (hipMemsetAsync((char*)d_ws + WS_BAR, 0, 16384, stream) != hipSuccess) { fprintf(stderr, "kernel_launch: memset failed\n"); return; }
#if MK_SPLIT
    for (int ph = 0; ph < N_PHASES; ++ph) {
        hipLaunchKernelGGL(mk_fwd, dim3(grid), dim3(512), LDS_BYTES, stream, p, ph, ph + 1);
    }
#else
    int lo = 0, hi = N_PHASES;
    void* args[] = {&p, &lo, &hi};
    hipError_t e = hipLaunchCooperativeKernel((const void*)mk_fwd, dim3(grid), dim3(512), args, LDS_BYTES, stream);
    if (e != hipSuccess) fprintf(stderr, "kernel_launch: cooperative launch failed: %s (grid %d)\n", hipGetErrorString(e), grid);
#endif
}
```

```cpp
#include <hip/hip_runtime.h>
#include <hip/hip_cooperative_groups.h>
#include <cstdio>
#include <cstdint>
namespace cg = cooperative_groups;
#ifndef MK_SPLIT
#define MK_SPLIT 0
#endif
namespace pg8 {
#define PG8_LAS __attribute__((address_space(3)))
typedef unsigned short bf16_t;
typedef short bf16x8 __attribute__((ext_vector_type(8)));
typedef float f32x4 __attribute__((ext_vector_type(4)));
typedef unsigned u32x4 __attribute__((ext_vector_type(4)));
constexpr int BM = 256, BK = 64, HALF = 128, HTB = HALF * BK * 2  , STAGE_BYTES = 8 * HTB, NXCD = 8, WGM = 8;

__host__ __device__ __forceinline__ int lds_byte(int r, int c) { const int st = (r >> 4) * 2 + (c >> 5), rr = r & 15, cc = c & 31, ob = rr * 64 + cc * 2; return st * 1024 + (ob ^ (((ob >> 9) & 1) << 5)); }
__host__ __device__ __forceinline__ void stage_rc(int b, int& R, int& C) { const int st = b / 1024, sb = b % 1024, swz = sb ^ (((sb >> 9) & 1) << 5); R = (st >> 1) * 16 + swz / 64; C = (st & 1) * 32 + (swz % 64) / 2; }
__host__ __device__ __forceinline__ int perm32(int rho) { const int n = rho >> 4, i = rho & 15; return 8 * (i >> 2) + 4 * n + (i & 3); }

struct Unit { int pm, pn; };
struct Gemm { const bf16_t* A; const bf16_t* Bt; int M, N, K; };

struct StaticOrder {
    int nM, nN, nwg, G, c;
    __host__ __device__ void init(int M, int N, int G_, int c_) { nM = M / BM; nN = N / BM; nwg = nM * nN; G = G_; c = c_; }
    __host__ __device__ bool next(int i, Unit& u) const {
        const long L = (long)i * G + c; if (L >= nwg) return false;
        int wgid = (int)L; { const int q = nwg / NXCD, r = nwg % NXCD, xcd = wgid % NXCD, off = wgid / NXCD; wgid = (xcd < r ? xcd * (q + 1) : r * (q + 1) + (xcd - r) * q) + off; }
        const int nig = WGM * nN, gid = wgid / nig, fm = gid * WGM, gsz = (nM - fm) < WGM ? (nM - fm) : WGM;
        u.pm = fm + ((wgid % nig) % gsz); u.pn = (wgid % nig) / gsz; return true;
    }
    __device__ __forceinline__ void a_ready(const Unit&) const {}
    __device__ __forceinline__ void done(const Unit&) const {}
};
typedef float cvt_f32x2_t __attribute__((ext_vector_type(2))); typedef __bf16 cvt_bf16x2_t __attribute__((ext_vector_type(2)));
__device__ __forceinline__ unsigned cvt_pk_bf16(float lo, float hi) { cvt_f32x2_t v = {lo, hi}; cvt_bf16x2_t b = __builtin_convertvector(v, cvt_bf16x2_t); return __builtin_bit_cast(unsigned, b); }
typedef float f32x2 __attribute__((ext_vector_type(2)));

template <class Epi, class Sched, bool ALIGN_EPI = false, bool SP2 = false>
__device__ __forceinline__ void gemm_phase(PG8_LAS unsigned char* lds, const Gemm g, const Sched& S, const Epi& E) {
    const int tid = threadIdx.x, wid = __builtin_amdgcn_readfirstlane(tid >> 6), lane = tid & 63, wr = wid >> 2, wc = wid & 3, fr = lane & 15, fq = lane >> 4;
    const int K = g.K, nt = K / BK;
    unsigned voffA[2], voffB[2];
#pragma unroll
    for (int i = 0; i < 2; ++i) { int R, C; stage_rc(tid * 16 + i * 8192, R, C); const int Rb = Epi::PERM ? ((R & ~31) + perm32(R & 31)) : R;
        voffA[i] = (unsigned)(R * K + C) * 2u; voffB[i] = (unsigned)(Rb * K + C) * 2u; }
    const size_t kstep = (size_t)(BK * 2);
    const size_t hstep = (size_t)HALF * K * 2;
    const size_t tstep = 2 * hstep;
    const unsigned ldsw = (unsigned)wid * 1024u;
    const int aoff = lds_byte(wr * 64 + fr, fq * 8), boff = lds_byte(wc * 32 + fr, fq * 8);
#define PG8_SA(b, h) (((b) * 2 + (h)) * HTB)
#define PG8_SB(b, h) ((4 + (b) * 2 + (h)) * HTB)
#define PG8_STAGE(bufoff, gbase, voff) do { _Pragma("unroll") for (int _i = 0; _i < 2; ++_i) \
        __builtin_amdgcn_global_load_lds((const unsigned*)((const char*)(gbase) + (voff)[_i]), (PG8_LAS unsigned*)(lds + (bufoff) + ldsw + _i * 8192), 16, 0, 0); } while (0)
#define PG8_LDA(dst, b, h) do { _Pragma("unroll") for (int m = 0; m < 4; ++m) _Pragma("unroll") for (int k = 0; k < 2; ++k) dst[m][k] = *(const PG8_LAS bf16x8*)(lds + PG8_SA(b, h) + aoff + m * 2048 + k * 1024); } while (0)
#define PG8_LDB(dst, b, h) do { _Pragma("unroll") for (int n = 0; n < 2; ++n) _Pragma("unroll") for (int k = 0; k < 2; ++k) dst[n][k] = *(const PG8_LAS bf16x8*)(lds + PG8_SB(b, h) + boff + n * 2048 + k * 1024); } while (0)
#define PG8_MMA(ai, bj, At, Bt) do { __builtin_amdgcn_s_setprio(1); _Pragma("unroll") for (int m = 0; m < 4; ++m) _Pragma("unroll") for (int n = 0; n < 2; ++n) _Pragma("unroll") for (int k = 0; k < 2; ++k) \
        acc[ai][bj][m][n] = __builtin_amdgcn_mfma_f32_16x16x32_bf16(Bt[n][k], At[m][k], acc[ai][bj][m][n], 0, 0, 0); __builtin_amdgcn_s_setprio(0); } while (0)
#define PG8_WAIT_V(n) asm volatile("s_waitcnt vmcnt(" #n ")" ::: "memory")
#define PG8_WAIT_L(n) asm volatile("s_waitcnt lgkmcnt(" #n ")" ::: "memory")
#define PG8_BAR __builtin_amdgcn_s_barrier()
#define PG8_SCHED __builtin_amdgcn_sched_barrier(0)
    Unit cur, nxt; int ui = 0;
    if (!S.next(0, cur)) return;
    f32x4 acc[2][2][4][2];
#pragma unroll
    for (int a = 0; a < 2; ++a)
#pragma unroll
        for (int b = 0; b < 2; ++b)
#pragma unroll
            for (int m = 0; m < 4; ++m)
#pragma unroll
                for (int n = 0; n < 2; ++n) acc[a][b][m][n] = (f32x4){0.f, 0.f, 0.f, 0.f};
    bf16x8 At[4][2], B0[2][2], B1[2][2];
    const char* cA = (const char*)g.A + (size_t)cur.pm * tstep; const char* cB = (const char*)g.Bt + (size_t)cur.pn * tstep;
    S.a_ready(cur);
    typename Epi::Pre pre; E.prefetch(pre, cur, wr, fr); __builtin_amdgcn_sched_barrier(0);
    if constexpr (SP2) {
        PG8_STAGE(PG8_SB(0, 0), cB, voffB); PG8_STAGE(PG8_SB(0, 1), cB + hstep, voffB); PG8_STAGE(PG8_SA(0, 0), cA, voffA); PG8_STAGE(PG8_SA(0, 1), cA + hstep, voffA);
        if (wr == 1) PG8_BAR;
        PG8_WAIT_V(2); PG8_BAR;
        PG8_STAGE(PG8_SB(1, 0), cB + kstep, voffB); PG8_STAGE(PG8_SA(1, 0), cA + kstep, voffA); PG8_STAGE(PG8_SB(1, 1), cB + hstep + kstep, voffB);
        PG8_WAIT_V(6); PG8_BAR;
    } else {
        PG8_STAGE(PG8_SB(0, 0), cB, voffB); PG8_STAGE(PG8_SA(0, 0), cA, voffA); PG8_STAGE(PG8_SB(0, 1), cB + hstep, voffB); PG8_STAGE(PG8_SA(0, 1), cA + hstep, voffA);
        if (wr == 1) PG8_BAR;
        PG8_WAIT_V(4); PG8_BAR;
        PG8_STAGE(PG8_SB(1, 0), cB + kstep, voffB); PG8_STAGE(PG8_SA(1, 0), cA + kstep, voffA); PG8_STAGE(PG8_SB(1, 1), cB + hstep + kstep, voffB);
        PG8_WAIT_V(6); PG8_BAR;
    }
    for (;;) {
        const bool has_next = S.next(ui + 1, nxt);
        const char* nA = has_next ? (const char*)g.A + (size_t)nxt.pm * tstep : cA; const char* nB = has_next ? (const char*)g.Bt + (size_t)nxt.pn * tstep : cB;
        for (int t = 0; t < nt; t += 2) {
            const bool last = (t == nt - 2);
            const char* a1 = cA + (size_t)(t + 1) * kstep;
            const char* a2 = last ? nA : cA + (size_t)(t + 2) * kstep; const char* b2 = last ? nB : cB + (size_t)(t + 2) * kstep;
            const char* a3 = a2 + kstep; const char* b3 = b2 + kstep;
            if (last && has_next) S.a_ready(nxt);
            if constexpr (SP2) {
            PG8_LDB(B0, 0, 0); PG8_LDB(B1, 0, 1); PG8_SCHED; PG8_LDA(At, 0, 0); PG8_STAGE(PG8_SA(1, 1), a1 + hstep, voffA);
            PG8_WAIT_V(8); PG8_WAIT_L(0); PG8_BAR; PG8_MMA(0, 0, At, B0); PG8_MMA(0, 1, At, B1); PG8_BAR; PG8_SCHED;
            PG8_LDA(At, 0, 1); PG8_STAGE(PG8_SB(0, 0), b2, voffB); PG8_STAGE(PG8_SB(0, 1), b2 + hstep, voffB); PG8_STAGE(PG8_SA(0, 0), a2, voffA);
            PG8_WAIT_V(8); PG8_WAIT_L(0); PG8_BAR; PG8_MMA(1, 0, At, B0); PG8_MMA(1, 1, At, B1); PG8_BAR; PG8_SCHED;
            PG8_LDB(B0, 1, 0); PG8_LDB(B1, 1, 1); PG8_SCHED; PG8_LDA(At, 1, 0); PG8_STAGE(PG8_SA(0, 1), a2 + hstep, voffA);
            PG8_WAIT_V(8); PG8_WAIT_L(0); PG8_BAR; PG8_MMA(0, 0, At, B0); PG8_MMA(0, 1, At, B1); PG8_BAR; PG8_SCHED;
            PG8_LDA(At, 1, 1); PG8_STAGE(PG8_SB(1, 0), b3, voffB); PG8_STAGE(PG8_SB(1, 1), b3 + hstep, voffB); PG8_STAGE(PG8_SA(1, 0), a3, voffA);
            PG8_WAIT_V(8); PG8_WAIT_L(0); PG8_BAR; PG8_MMA(1, 0, At, B0); PG8_MMA(1, 1, At, B1); PG8_BAR; PG8_SCHED;
            } else {
            PG8_LDB(B0, 0, 0); PG8_SCHED; PG8_LDA(At, 0, 0); PG8_STAGE(PG8_SA(1, 1), a1 + hstep, voffA);
            PG8_WAIT_L(8); PG8_BAR; PG8_WAIT_L(0); PG8_MMA(0, 0, At, B0); PG8_BAR; PG8_SCHED;
            PG8_LDB(B1, 0, 1); PG8_STAGE(PG8_SB(0, 0), b2, voffB);
            PG8_BAR; PG8_WAIT_L(0); PG8_MMA(0, 1, At, B1); PG8_BAR;
            PG8_LDA(At, 0, 1); PG8_STAGE(PG8_SA(0, 0), a2, voffA);
            PG8_BAR; PG8_WAIT_L(0); PG8_MMA(1, 0, At, B0); PG8_BAR; PG8_SCHED;
            PG8_STAGE(PG8_SB(0, 1), b2 + hstep, voffB);
            PG8_WAIT_V(6); PG8_BAR; PG8_MMA(1, 1, At, B1); PG8_BAR;
            PG8_LDB(B0, 1, 0); PG8_SCHED; PG8_LDA(At, 1, 0); PG8_STAGE(PG8_SA(0, 1), a2 + hstep, voffA);
            PG8_WAIT_L(8); PG8_BAR; PG8_WAIT_L(0); PG8_MMA(0, 0, At, B0); PG8_BAR; PG8_SCHED;
            PG8_LDB(B1, 1, 1); PG8_STAGE(PG8_SB(1, 0), b3, voffB);
            PG8_BAR; PG8_WAIT_L(0); PG8_MMA(0, 1, At, B1); PG8_BAR;
            PG8_LDA(At, 1, 1); PG8_STAGE(PG8_SA(1, 0), a3, voffA);
            PG8_BAR; PG8_WAIT_L(0); PG8_MMA(1, 0, At, B0); PG8_BAR; PG8_SCHED;
            PG8_STAGE(PG8_SB(1, 1), b3 + hstep, voffB);
            PG8_WAIT_V(6); PG8_BAR; PG8_MMA(1, 1, At, B1); PG8_BAR;
            }
        }
        if constexpr (ALIGN_EPI) { if (wr == 0) PG8_BAR; }
        if constexpr (!Epi::AFTER_DRAIN) { E(acc, cur, wr, wc, fr, fq, pre); S.done(cur); }
        if (!has_next) break;
#pragma unroll
        for (int a = 0; a < 2; ++a)
#pragma unroll
            for (int b = 0; b < 2; ++b)
#pragma unroll
                for (int m = 0; m < 4; ++m)
#pragma unroll
                    for (int n = 0; n < 2; ++n) acc[a][b][m][n] = (f32x4){0.f, 0.f, 0.f, 0.f};
        cur = nxt; cA = nA; cB = nB; ++ui;
        E.prefetch(pre, cur, wr, fr); __builtin_amdgcn_sched_barrier(0);
        if constexpr (ALIGN_EPI) { if (wr == 1) PG8_BAR; }
    }
    PG8_WAIT_V(0);
    if constexpr (!ALIGN_EPI) { if (wr == 0) PG8_BAR; }
    PG8_BAR;
    if constexpr (Epi::AFTER_DRAIN) { E.fused(acc, cur, wr, wc, fr, fq, lds, wid, lane); S.done(cur); }
#undef PG8_SA
#undef PG8_SB
#undef PG8_STAGE
#undef PG8_LDA
#undef PG8_LDB
#undef PG8_MMA
#undef PG8_WAIT_V
#undef PG8_WAIT_L
#undef PG8_BAR
#undef PG8_SCHED
}
}

constexpr int T_TOK = 16384, SEQ = 2048, DM = 1024, DFF = 2816, NPROJ = 3584;
constexpr float RMS_EPS = 1e-6f;
constexpr size_t MiB = 1u << 20;
constexpr size_t WS_SS = 0;
constexpr size_t WS_DEC = 512 * 1024;
constexpr size_t WS_ROPE = 1 * MiB;
constexpr size_t WS_W_INREC = 2 * MiB, WS_W_OUTREC = 9 * MiB, WS_W_QKV = 11 * MiB, WS_W_O = 17 * MiB;
constexpr size_t WS_W_FFNIN0 = 19 * MiB, WS_W_FFNIN1 = 30 * MiB, WS_W_FFNOUT0 = 41 * MiB, WS_W_FFNOUT1 = 46 * MiB + 512 * 1024;
constexpr size_t WS_XB = 52 * MiB;
constexpr size_t WS_MIX = 84 * MiB;
constexpr size_t WS_BIG = 116 * MiB;
constexpr size_t WS_OB2 = 212 * MiB;
constexpr size_t WS_LSE = 244 * MiB;
constexpr size_t WS_END = 247 * MiB;
constexpr int LDS_BYTES = 147456 + 256;
constexpr int LDS_MISC = 147456;
constexpr size_t WS_BAR = 384 * 1024;

typedef unsigned short bf16;
using pg8::bf16x8; using pg8::f32x4; using pg8::u32x4;
typedef float f32x16 __attribute__((ext_vector_type(16)));
typedef unsigned u32x2 __attribute__((ext_vector_type(2)));

struct Params {
    const float *x, *mix_norm, *ffn_norm, *w_in_rec, *conv_w, *hgrn_lb, *hgrn_norm, *w_out_rec, *w_qkv, *w_o, *w_ffn_in, *w_ffn_out, *final_norm;
    float* out; unsigned char* ws;
};

typedef float f32x2_t __attribute__((ext_vector_type(2)));
typedef __bf16 bf16x2_t __attribute__((ext_vector_type(2)));
__device__ __forceinline__ unsigned pk2(float lo, float hi) { f32x2_t v = {lo, hi}; bf16x2_t b = __builtin_convertvector(v, bf16x2_t); return __builtin_bit_cast(unsigned, b); }
__device__ __forceinline__ unsigned f2bf(float f) { return pk2(f, 0.f) & 0xffffu; }
__device__ __forceinline__ float bf2f(unsigned short b) { return __builtin_bit_cast(float, (unsigned)b << 16); }
__device__ __forceinline__ float bflo(unsigned u) { return __builtin_bit_cast(float, u << 16); }
__device__ __forceinline__ float bfhi(unsigned u) { return __builtin_bit_cast(float, u & 0xffff0000u); }
__device__ __forceinline__ float wave_sum(float v) {
#pragma unroll
    for (int o = 1; o < 64; o <<= 1) v += __shfl_xor(v, o);
    return v;
}
__device__ __forceinline__ float xor32_max(float x) { const unsigned xi = __builtin_bit_cast(unsigned, x); auto r = __builtin_amdgcn_permlane32_swap(xi, xi, false, false); return fmaxf(__builtin_bit_cast(float, (unsigned)r[0]), __builtin_bit_cast(float, (unsigned)r[1])); }
__device__ __forceinline__ float xor32_sum(float x) { const unsigned xi = __builtin_bit_cast(unsigned, x); auto r = __builtin_amdgcn_permlane32_swap(xi, xi, false, false); return __builtin_bit_cast(float, (unsigned)r[0]) + __builtin_bit_cast(float, (unsigned)r[1]); }
__device__ __forceinline__ float sigmoidf_(float z) { return __builtin_amdgcn_rcpf(1.f + __expf(-z)); }

namespace pg8 {
#ifndef MK_WT_STORES
#define MK_WT_STORES 1
#endif
__device__ __forceinline__ void st16(void* p, u32x4 v) {
#if MK_WT_STORES
    asm volatile("global_store_dwordx4 %0, %1, off sc1\n\ts_nop 1" :: "v"(p), "v"(v) : "memory");
#else
    *(u32x4*)p = v;
#endif
}
struct EpiScaleBf16 {
    static constexpr bool PERM = true, AFTER_DRAIN = false;
    bf16_t* O; int ldc; const float* ss;
    struct Pre { float ssv[2][4]; };
    __device__ __forceinline__ void prefetch(Pre& pre, const Unit& u, int wr, int fr) const {
#pragma unroll
        for (int ai = 0; ai < 2; ++ai)
#pragma unroll
            for (int m = 0; m < 4; ++m) pre.ssv[ai][m] = ss[u.pm * BM + wr * 64 + fr + ai * HALF + m * 16];
    }
    __device__ __forceinline__ void operator()(const f32x4 (&acc)[2][2][4][2], const Unit& u, int wr, int wc, int fr, int fq, const Pre& pre) const {
        const int row0 = u.pm * BM + wr * 64 + fr, col0 = u.pn * BM + wc * 32 + 8 * fq;
#pragma unroll
        for (int ai = 0; ai < 2; ++ai)
#pragma unroll
            for (int m = 0; m < 4; ++m) {
                const int row = row0 + ai * HALF + m * 16;
                const float r = rsqrtf(pre.ssv[ai][m] * (1.f / 1024.f) + 1e-6f);
                bf16_t* rowp = O + (size_t)row * ldc + col0;
#pragma unroll
                for (int bj = 0; bj < 2; ++bj) {
                    const f32x4 v0 = acc[ai][bj][m][0] * r, v1 = acc[ai][bj][m][1] * r;
                    u32x4 w; w.x = cvt_pk_bf16(v0[0], v0[1]); w.y = cvt_pk_bf16(v0[2], v0[3]); w.z = cvt_pk_bf16(v1[0], v1[1]); w.w = cvt_pk_bf16(v1[2], v1[3]);
                    st16(rowp + bj * HALF, w);
                }
            }
    }
};
struct EpiSwiGLU {
    static constexpr bool PERM = true, AFTER_DRAIN = false;
    bf16_t* H; const float* ss;
    struct Pre { float ssv[2][4]; };
    __device__ __forceinline__ void prefetch(Pre& pre, const Unit& u, int wr, int fr) const {
#pragma unroll
        for (int ai = 0; ai < 2; ++ai)
#pragma unroll
            for (int m = 0; m < 4; ++m) pre.ssv[ai][m] = ss[u.pm * BM + wr * 64 + fr + ai * HALF + m * 16];
    }
    __device__ __forceinline__ void operator()(const f32x4 (&acc)[2][2][4][2], const Unit& u, int wr, int wc, int fr, int fq, const Pre& pre) const {
        const int row0 = u.pm * BM + wr * 64 + fr, col0 = u.pn * HALF + wc * 32 + 8 * fq;
#pragma unroll
        for (int ai = 0; ai < 2; ++ai)
#pragma unroll
            for (int m = 0; m < 4; ++m) {
                const int row = row0 + ai * HALF + m * 16;
                const float r = rsqrtf(pre.ssv[ai][m] * (1.f / 1024.f) + 1e-6f);
                float o[8];
#pragma unroll
                for (int n = 0; n < 2; ++n)
#pragma unroll
                    for (int j = 0; j < 4; ++j) {
                        const float g = acc[ai][0][m][n][j] * r, up = acc[ai][1][m][n][j] * r;
                        o[4 * n + j] = g * up * __builtin_amdgcn_rcpf(1.f + __expf(-g));
                    }
                u32x4 w; w.x = cvt_pk_bf16(o[0], o[1]); w.y = cvt_pk_bf16(o[2], o[3]); w.z = cvt_pk_bf16(o[4], o[5]); w.w = cvt_pk_bf16(o[6], o[7]);
                st16(H + (size_t)row * 2816 + col0, w);
            }
    }
};
struct EpiQKV {
    static constexpr bool PERM = true, AFTER_DRAIN = false;
    bf16_t* QKV; const float* ss; const float* rope;
    struct Pre { float ssv[2][4]; };
    __device__ __forceinline__ void prefetch(Pre& pre, const Unit& u, int wr, int fr) const {
#pragma unroll
        for (int ai = 0; ai < 2; ++ai)
#pragma unroll
            for (int m = 0; m < 4; ++m) pre.ssv[ai][m] = ss[u.pm * BM + wr * 64 + fr + ai * HALF + m * 16];
    }
    __device__ __forceinline__ void operator()(const f32x4 (&acc)[2][2][4][2], const Unit& u, int wr, int wc, int fr, int fq, const Pre& pre) const {
        const int row0 = u.pm * BM + wr * 64 + fr;
        const int t = u.pn >> 2, head = 4 * (u.pn & 3) + wc;
        bf16_t* base = QKV + (size_t)t * ((size_t)16384 * 1024) + (size_t)head * (2048 * 64) + 8 * fq;
        const float qs = (t == 0) ? 0.125f : 1.f;
#pragma unroll
        for (int ai = 0; ai < 2; ++ai)
#pragma unroll
            for (int m = 0; m < 4; ++m) {
                const int row = row0 + ai * HALF + m * 16;
                const float r = rsqrtf(pre.ssv[ai][m] * (1.f / 1024.f) + 1e-6f) * qs;
                float y1[8], y2[8];
                if (t < 2) {
                    const float* cs = rope + (size_t)(row & 2047) * 64 + 8 * fq;
                    const f32x4 c0 = *(const f32x4*)(cs), c1 = *(const f32x4*)(cs + 4), s0 = *(const f32x4*)(cs + 32), s1 = *(const f32x4*)(cs + 36);
#pragma unroll
                    for (int j = 0; j < 4; ++j) {
                        const float a0 = acc[ai][0][m][0][j] * r, b0 = acc[ai][1][m][0][j] * r, a1 = acc[ai][0][m][1][j] * r, b1 = acc[ai][1][m][1][j] * r;
                        y1[j] = a0 * c0[j] - b0 * s0[j]; y2[j] = a0 * s0[j] + b0 * c0[j];
                        y1[4 + j] = a1 * c1[j] - b1 * s1[j]; y2[4 + j] = a1 * s1[j] + b1 * c1[j];
                    }
                } else {
#pragma unroll
                    for (int j = 0; j < 4; ++j) { y1[j] = acc[ai][0][m][0][j] * r; y2[j] = acc[ai][1][m][0][j] * r; y1[4 + j] = acc[ai][0][m][1][j] * r; y2[4 + j] = acc[ai][1][m][1][j] * r; }
                }
                u32x4 w1, w2;
                w1.x = cvt_pk_bf16(y1[0], y1[1]); w1.y = cvt_pk_bf16(y1[2], y1[3]); w1.z = cvt_pk_bf16(y1[4], y1[5]); w1.w = cvt_pk_bf16(y1[6], y1[7]);
                w2.x = cvt_pk_bf16(y2[0], y2[1]); w2.y = cvt_pk_bf16(y2[2], y2[3]); w2.z = cvt_pk_bf16(y2[4], y2[5]); w2.w = cvt_pk_bf16(y2[6], y2[7]);
                bf16_t* rp = base + (size_t)(row >> 11) * (16 * 2048 * 64) + (size_t)(row & 2047) * 64;
                st16(rp, w1); st16(rp + 32, w2);
            }
    }
};
struct EpiResid {
    static constexpr bool PERM = true, AFTER_DRAIN = false;
    const float* x32; const bf16_t* xb; bf16_t* XB; float* ssout;
    struct Pre {};
    __device__ __forceinline__ void prefetch(Pre&, const Unit&, int, int) const {}
    __device__ __forceinline__ void operator()(const f32x4 (&acc)[2][2][4][2], const Unit& u, int wr, int wc, int fr, int fq, const Pre& pre) const {
        const int row0 = u.pm * BM + wr * 64 + fr, col0 = u.pn * BM + wc * 32 + 8 * fq;
        float srow[2][4];
#pragma unroll
        for (int ai = 0; ai < 2; ++ai) {
            f32x4 xr[4][2][2];
            if (x32) {
#pragma unroll
                for (int m = 0; m < 4; ++m)
#pragma unroll
                    for (int bj = 0; bj < 2; ++bj) { const float* px = x32 + (size_t)(row0 + ai * HALF + m * 16) * 1024 + col0 + bj * HALF; xr[m][bj][0] = *(const f32x4*)(px); xr[m][bj][1] = *(const f32x4*)(px + 4); }
            } else {
                u32x4 xv[4][2];
#pragma unroll
                for (int m = 0; m < 4; ++m)
#pragma unroll
                    for (int bj = 0; bj < 2; ++bj) xv[m][bj] = *(const u32x4*)(xb + (size_t)(row0 + ai * HALF + m * 16) * 1024 + col0 + bj * HALF);
#pragma unroll
                for (int m = 0; m < 4; ++m)
#pragma unroll
                    for (int bj = 0; bj < 2; ++bj) {
                        const u32x4 v = xv[m][bj];
                        xr[m][bj][0] = (f32x4){__builtin_bit_cast(float, v.x << 16), __builtin_bit_cast(float, v.x & 0xffff0000u), __builtin_bit_cast(float, v.y << 16), __builtin_bit_cast(float, v.y & 0xffff0000u)};
                        xr[m][bj][1] = (f32x4){__builtin_bit_cast(float, v.z << 16), __builtin_bit_cast(float, v.z & 0xffff0000u), __builtin_bit_cast(float, v.w << 16), __builtin_bit_cast(float, v.w & 0xffff0000u)};
                    }
            }
#pragma unroll
            for (int m = 0; m < 4; ++m) {
                const size_t off = (size_t)(row0 + ai * HALF + m * 16) * 1024 + col0;
                float s = 0.f;
#pragma unroll
                for (int bj = 0; bj < 2; ++bj) {
                    const f32x4 v0 = acc[ai][bj][m][0] + xr[m][bj][0], v1 = acc[ai][bj][m][1] + xr[m][bj][1];
                    u32x4 w; w.x = cvt_pk_bf16(v0[0], v0[1]); w.y = cvt_pk_bf16(v0[2], v0[3]); w.z = cvt_pk_bf16(v1[0], v1[1]); w.w = cvt_pk_bf16(v1[2], v1[3]);
                    st16(XB + off + bj * HALF, w);
                    const float r0 = __builtin_bit_cast(float, w.x << 16), r1 = __builtin_bit_cast(float, w.x & 0xffff0000u), r2 = __builtin_bit_cast(float, w.y << 16), r3 = __builtin_bit_cast(float, w.y & 0xffff0000u);
                    const float r4 = __builtin_bit_cast(float, w.z << 16), r5 = __builtin_bit_cast(float, w.z & 0xffff0000u), r6 = __builtin_bit_cast(float, w.w << 16), r7 = __builtin_bit_cast(float, w.w & 0xffff0000u);
                    s += (r0 * r0 + r1 * r1) + (r2 * r2 + r3 * r3) + (r4 * r4 + r5 * r5) + (r6 * r6 + r7 * r7);
                }
                srow[ai][m] = s;
            }
        }
#pragma unroll
        for (int ai = 0; ai < 2; ++ai)
#pragma unroll
            for (int m = 0; m < 4; ++m) srow[ai][m] += __shfl_xor(srow[ai][m], 16);
#pragma unroll
        for (int ai = 0; ai < 2; ++ai)
#pragma unroll
            for (int m = 0; m < 4; ++m) srow[ai][m] += __shfl_xor(srow[ai][m], 32);
        if (fq == 0) {
#pragma unroll
            for (int ai = 0; ai < 2; ++ai)
#pragma unroll
                for (int m = 0; m < 4; ++m) atomicAdd(ssout + row0 + ai * HALF + m * 16, srow[ai][m]);
        }
    }
};
}

__device__ __forceinline__ int src_col(int kind, int n) {
    if (kind == 0) return n;
    const int pn = n >> 8, bj = (n >> 7) & 1, c = n & 127;
    if (kind == 1) return bj * 2816 + 128 * pn + c;
    const int t = pn >> 2, head = 4 * (pn & 3) + (c >> 5), i = c & 31;
    return t * 1024 + head * 64 + bj * 32 + i;
}
__device__ __forceinline__ void convert_tile(const float* __restrict__ W, bf16* __restrict__ Bt, int K, int N, const float* __restrict__ gain, int kind, int tile, float* Tl) {
    const int ntn = N >> 8; const int kt = tile / ntn, nt = tile - kt * ntn; const int k0 = kt * 64, n0 = nt * 256;
    const int tid = threadIdx.x;
    {
        f32x4 v[8];
        const int n4 = (tid & 63) * 4; const int sc = src_col(kind, n0 + n4);
#pragma unroll
        for (int i = 0; i < 8; ++i) { const int kk = i * 8 + (tid >> 6); v[i] = *(const f32x4*)(W + (size_t)(k0 + kk) * N + sc); }
        if (gain) {
#pragma unroll
            for (int i = 0; i < 8; ++i) v[i] = v[i] * gain[k0 + i * 8 + (tid >> 6)];
        }
#pragma unroll
        for (int i = 0; i < 8; ++i) { const int kk = i * 8 + (tid >> 6); *(f32x4*)(Tl + kk * 260 + n4) = v[i]; }
    }
    __syncthreads();
    {
        const int n = tid & 255, chalf = tid >> 8;
#pragma unroll
        for (int i = 0; i < 4; ++i) {
            const int c = 2 * i + chalf; const float* sp = Tl + (8 * c) * 260 + n;
            u32x4 o; o.x = pg8::cvt_pk_bf16(sp[0], sp[260]); o.y = pg8::cvt_pk_bf16(sp[520], sp[780]); o.z = pg8::cvt_pk_bf16(sp[1040], sp[1300]); o.w = pg8::cvt_pk_bf16(sp[1560], sp[1820]);
            *(u32x4*)(Bt + (size_t)(n0 + n) * K + k0 + 8 * c) = o;
        }
    }
    __syncthreads();
}

__device__ __forceinline__ void convert_items(const Params& p, unsigned char* smem, int lo, int hi, int first, int stride) {
    float* Tl = (float*)smem;
    for (int item = lo + first; item < hi; item += stride) {
        int t = item; const float* W; bf16* Bt; int K, N, kind; const float* gain;
        if (t < 224) { W = p.w_in_rec; Bt = (bf16*)(p.ws + WS_W_INREC); K = 1024; N = 3584; kind = 0; gain = p.mix_norm; }
        else if ((t -= 224) < 64) { W = p.w_out_rec; Bt = (bf16*)(p.ws + WS_W_OUTREC); K = 1024; N = 1024; kind = 0; gain = nullptr; }
        else if ((t -= 64) < 352) { W = p.w_ffn_in; Bt = (bf16*)(p.ws + WS_W_FFNIN0); K = 1024; N = 5632; kind = 1; gain = p.ffn_norm; }
        else if ((t -= 352) < 176) { W = p.w_ffn_out; Bt = (bf16*)(p.ws + WS_W_FFNOUT0); K = 2816; N = 1024; kind = 0; gain = nullptr; }
        else if ((t -= 176) < 192) { W = p.w_qkv; Bt = (bf16*)(p.ws + WS_W_QKV); K = 1024; N = 3072; kind = 2; gain = p.mix_norm + 1024; }
        else if ((t -= 192) < 64) { W = p.w_o; Bt = (bf16*)(p.ws + WS_W_O); K = 1024; N = 1024; kind = 0; gain = nullptr; }
        else if ((t -= 64) < 352) { W = p.w_ffn_in + (size_t)1024 * 5632; Bt = (bf16*)(p.ws + WS_W_FFNIN1); K = 1024; N = 5632; kind = 1; gain = p.ffn_norm + 1024; }
        else { t -= 352; W = p.w_ffn_out + (size_t)2816 * 1024; Bt = (bf16*)(p.ws + WS_W_FFNOUT1); K = 2816; N = 1024; kind = 0; gain = nullptr; }
        convert_tile(W, Bt, K, N, gain, kind, t, Tl);
    }
}
#ifndef CONV_SPLIT2
#define CONV_SPLIT2 816
#endif
#ifndef CONV_SPLIT
#define CONV_SPLIT 224
#endif

__device__ __forceinline__ void phase_prologue(const Params& p, unsigned char* smem) {
    const int tid = threadIdx.x, lane = tid & 63, wave = tid >> 6;
    convert_items(p, smem, 0, CONV_SPLIT, blockIdx.x, gridDim.x);
    {
        float* ss = (float*)(p.ws + WS_SS); bf16* XB = (bf16*)(p.ws + WS_XB);
        for (int row = blockIdx.x * 8 + wave; row < T_TOK; row += gridDim.x * 8) {
            const f32x4* xr = (const f32x4*)(p.x + (size_t)row * 1024) + lane;
            f32x4 v[4]; float s = 0.f;
#pragma unroll
            for (int j = 0; j < 4; ++j) { v[j] = xr[64 * j]; s += (v[j][0] * v[j][0] + v[j][1] * v[j][1]) + (v[j][2] * v[j][2] + v[j][3] * v[j][3]); }
            s = wave_sum(s);
            u32x2* o = (u32x2*)(XB + (size_t)row * 1024) + lane;
#pragma unroll
            for (int j = 0; j < 4; ++j) { u32x2 w; w.x = pk2(v[j][0], v[j][1]); w.y = pk2(v[j][2], v[j][3]); o[64 * j] = w; }
            if (lane == 0) ss[row] = s;
        }
        for (int i = blockIdx.x * 512 + tid; i < 4 * T_TOK; i += gridDim.x * 512) ss[T_TOK + i] = 0.f;
    }
    {
        float* rope = (float*)(p.ws + WS_ROPE);
        for (int i = blockIdx.x * 512 + tid; i < SEQ * 32; i += gridDim.x * 512) {
            const int pos = i >> 5, f = i & 31;
            const float freq = exp2f(-(float)f * (13.287712379549449f / 32.f));
            const float ang = (float)pos * freq;
            const double a = (double)ang; const double kq = rint(a * 0.15915494309189535); const float r = (float)(a - kq * 6.283185307179586);
            rope[pos * 64 + f] = __cosf(r); rope[pos * 64 + 32 + f] = __sinf(r);
        }
    }
}

__device__ __forceinline__ float hgrn_lb_of(const Params& p, int ch) {
    const float a = p.hgrn_lb[ch], b = p.hgrn_lb[512 + ch], c = p.hgrn_lb[1024 + ch];
    const float m = fmaxf(a, fmaxf(b, c)); const float ea = __expf(a - m), eb = __expf(b - m), ec = __expf(c - m);
    return eb * __builtin_amdgcn_rcpf(ea + eb + ec);
}

__device__ __forceinline__ void phase_conv(const Params& p) {
    const bf16* PROJ = (const bf16*)(p.ws + WS_BIG); bf16* MIX = (bf16*)(p.ws + WS_MIX);
    const int tid = threadIdx.x;
    for (int task = blockIdx.x * 512 + tid; task < T_TOK * 64; task += gridDim.x * 512) {
        const int tok = task >> 6, c8 = (task & 63) * 8; const int pos = tok & (SEQ - 1);
        const bf16* row = PROJ + (size_t)tok * NPROJ + c8;
        const u32x4 bg = *(const u32x4*)(row);
        float y[8];
#pragma unroll
        for (int e = 0; e < 8; ++e) y[e] = 0.f;
#pragma unroll
        for (int j = 0; j < 3; ++j) {
            const int back = 2 - j;
            if (pos >= back) {
                const bf16* rj = row - (size_t)back * NPROJ;
                const u32x4 cgv = *(const u32x4*)(rj + 512), vcv = *(const u32x4*)(rj + 1024);
                const f32x4 w0 = *(const f32x4*)(p.conv_w + j * 512 + c8), w1 = *(const f32x4*)(p.conv_w + j * 512 + c8 + 4);
#pragma unroll
                for (int q = 0; q < 4; ++q) {
                    const float wl = (q < 2) ? w0[2 * q] : w1[2 * q - 4], wh = (q < 2) ? w0[2 * q + 1] : w1[2 * q - 3];
                    y[2 * q] += wl * bflo(cgv[q]) * bflo(vcv[q]);
                    y[2 * q + 1] += wh * bfhi(cgv[q]) * bfhi(vcv[q]);
                }
            }
        }
        u32x4 o;
#pragma unroll
        for (int q = 0; q < 4; ++q) o[q] = pk2(y[2 * q] * bflo(bg[q]), y[2 * q + 1] * bfhi(bg[q]));
        *(u32x4*)(MIX + (size_t)tok * 1024 + c8) = o;
    }
}

#define MFMA16(a, b, c) __builtin_amdgcn_mfma_f32_16x16x32_bf16((a), (b), (c), 0, 0, 0)
#define MFMA32(a, b, c) __builtin_amdgcn_mfma_f32_32x32x16_bf16((a), (b), (c), 0, 0, 0)

__device__ __forceinline__ void phase_hgrn_a(const Params& p, unsigned char* smem) {
    const bf16* PROJ = (const bf16*)(p.ws + WS_BIG); bf16* UT = (bf16*)p.out; float* DEC = (float*)(p.ws + WS_DEC);
    bf16* KgT = (bf16*)smem;
    bf16* VT = KgT + 128 * 72;
    float* part = (float*)(smem + 2 * 128 * 72 * 2);
    const int tid = threadIdx.x, lane = tid & 63, wave = tid >> 6, fr = lane & 15, fq = lane >> 4;
    const int k = tid & 127, qd = tid >> 7;
    for (int item = blockIdx.x; item < 1024; item += gridDim.x) {
        const int bh = item >> 5, c = item & 31, b = bh >> 2, h = bh & 3;
        const int t0 = b * SEQ + c * 64;
        const float lb = hgrn_lb_of(p, h * 128 + k);
        const bf16* zp = PROJ + (size_t)(t0 + 16 * qd) * NPROJ + 2048 + h * 128 + k;
        float G[16], kk[16], vv[16];
        float run = 0.f;
#pragma unroll
        for (int i = 0; i < 16; ++i) {
            const float z = bf2f(zp[(size_t)i * NPROJ]); const float iv = bf2f(zp[(size_t)i * NPROJ + 512]);
            const float sg = sigmoidf_(z); const float f = lb + (1.f - lb) * sg;
            run += __logf(f); G[i] = run; kk[i] = 1.f - f; vv[i] = iv * sigmoidf_(iv);
        }
        part[qd * 128 + k] = run;
        __syncthreads();
        float off = 0.f, tot = 0.f;
#pragma unroll
        for (int q = 0; q < 4; ++q) { const float pv = part[q * 128 + k]; tot += pv; if (q < qd) off += pv; }
        {
            unsigned kw[8], vw[8];
#pragma unroll
            for (int i = 0; i < 8; ++i) {
                const float g0 = G[2 * i] + off, g1 = G[2 * i + 1] + off;
                kw[i] = pk2(kk[2 * i] * __expf(tot - g0), kk[2 * i + 1] * __expf(tot - g1));
                vw[i] = pk2(vv[2 * i], vv[2 * i + 1]);
            }
            u32x4* kd = (u32x4*)(KgT + k * 72 + 16 * qd); u32x4* vd = (u32x4*)(VT + k * 72 + 16 * qd);
            kd[0] = (u32x4){kw[0], kw[1], kw[2], kw[3]}; kd[1] = (u32x4){kw[4], kw[5], kw[6], kw[7]};
            vd[0] = (u32x4){vw[0], vw[1], vw[2], vw[3]}; vd[1] = (u32x4){vw[4], vw[5], vw[6], vw[7]};
        }
        if (qd == 0) DEC[item * 128 + k] = __expf(tot);
        __syncthreads();
        {
            const int mt = wave;
            bf16x8 a[2];
#pragma unroll
            for (int ks = 0; ks < 2; ++ks) a[ks] = *(const bf16x8*)(KgT + (16 * mt + fr) * 72 + 32 * ks + 8 * fq);
            bf16* ub = UT + (size_t)item * 16384 + 16 * mt + 4 * fq;
#pragma unroll
            for (int nt = 0; nt < 8; ++nt) {
                f32x4 acc = {0.f, 0.f, 0.f, 0.f};
#pragma unroll
                for (int ks = 0; ks < 2; ++ks) { const bf16x8 bb = *(const bf16x8*)(VT + (16 * nt + fr) * 72 + 32 * ks + 8 * fq); acc = MFMA16(a[ks], bb, acc); }
                { u32x2 w; w.x = pk2(acc[0], acc[1]); w.y = pk2(acc[2], acc[3]); *(u32x2*)(ub + (size_t)(16 * nt + fr) * 128) = w; }
            }
        }
        __syncthreads();
    }
}

__device__ __forceinline__ void phase_hgrn_b(const Params& p) {
    const bf16* UT = (const bf16*)p.out; const float* DEC = (const float*)(p.ws + WS_DEC); bf16* SP = (bf16*)p.out + (size_t)T_TOK * 1024;
    for (int e4 = blockIdx.x * 512 + threadIdx.x; e4 < 32 * 4096; e4 += gridDim.x * 512) {
        const int bh = e4 >> 12, r = e4 & 4095, k4 = (r & 31) * 4;
        f32x4 S = {0.f, 0.f, 0.f, 0.f};
#pragma unroll 8
        for (int c = 0; c < 32; ++c) {
            const int item = bh * 32 + c;
            u32x2 w; w.x = pk2(S[0], S[1]); w.y = pk2(S[2], S[3]);
            *(u32x2*)(SP + (size_t)item * 16384 + r * 4) = w;
            const f32x4 d = *(const f32x4*)(DEC + item * 128 + k4); const u32x2 uw = __builtin_nontemporal_load((const u32x2*)(UT + (size_t)item * 16384 + r * 4)); const f32x4 u = {bflo(uw.x), bfhi(uw.x), bflo(uw.y), bfhi(uw.y)};
            S = d * S + u;
        }
    }
}

__device__ __forceinline__ void phase_hgrn_c(const Params& p, unsigned char* smem) {
    const bf16* PROJ = (const bf16*)(p.ws + WS_BIG); const bf16* SP = (const bf16*)p.out + (size_t)T_TOK * 1024; bf16* MIX = (bf16*)(p.ws + WS_MIX);
    bf16* Am = (bf16*)smem;
    bf16* Bm = Am + 64 * 136;
    bf16* Qg = Bm + 64 * 136;
    bf16* VT = Qg + 64 * 136;
    bf16* P = VT + 128 * 72;
    float* part = (float*)(smem + 3 * 17408 + 18432 + 9216);
    float* rowss = part + 512;
    const int tid = threadIdx.x, lane = tid & 63, wave = tid >> 6, fr = lane & 15, fq = lane >> 4;
    const int k = tid & 127, qd = tid >> 7;
    typedef unsigned short us2 __attribute__((ext_vector_type(2)));
    us2 zi[16], qq[8];
    if ((int)blockIdx.x < 1024) {
        const int item = blockIdx.x; const int bh = item >> 5, c = item & 31, b = bh >> 2, h = bh & 3;
        const bf16* zp = PROJ + (size_t)(b * SEQ + c * 64 + 16 * qd) * NPROJ + 2048 + h * 128 + k;
#pragma unroll
        for (int i = 0; i < 16; ++i) { zi[i].x = zp[(size_t)i * NPROJ]; zi[i].y = zp[(size_t)i * NPROJ + 512]; if (i & 1) qq[i >> 1].y = zp[(size_t)i * NPROJ - 512]; else qq[i >> 1].x = zp[(size_t)i * NPROJ - 512]; }
    }
    for (int item = blockIdx.x; item < 1024; item += gridDim.x) {
        const int bh = item >> 5, c = item & 31, b = bh >> 2, h = bh & 3;
        const int t0 = b * SEQ + c * 64;
        const float lb = hgrn_lb_of(p, h * 128 + k);
        float G[16], kk[16], vv[16], qv[16];
        float run = 0.f;
#pragma unroll
        for (int i = 0; i < 16; ++i) {
            const float z = bf2f(zi[i].x); const float iv = bf2f(zi[i].y); qv[i] = bf2f((i & 1) ? qq[i >> 1].y : qq[i >> 1].x);
            const float sg = sigmoidf_(z); const float f = lb + (1.f - lb) * sg;
            run += __logf(f); G[i] = run; kk[i] = 1.f - f; vv[i] = iv * sigmoidf_(iv);
        }
        part[qd * 128 + k] = run;
#pragma unroll
        for (int i = 0; i < 16; ++i) {
            const int t = 16 * qd + i;
            Am[t * 136 + k] = (bf16)f2bf(qv[i] * __expf(G[i])); Bm[t * 136 + k] = (bf16)f2bf(kk[i] * __expf(run - G[i]));
        }
        for (int i = tid; i < 2304; i += 512) ((unsigned*)P)[i] = 0u;
        __syncthreads();
        float off = 0.f;
#pragma unroll
        for (int q = 0; q < 4; ++q) { const float pv = part[q * 128 + k]; if (q < qd) off += pv; }
        {
            unsigned vw[8];
#pragma unroll
            for (int i = 0; i < 16; ++i) {
                const float g = G[i] + off; const int t = 16 * qd + i;
                Qg[t * 136 + k] = (bf16)f2bf(qv[i] * __expf(g));
            }
#pragma unroll
            for (int i = 0; i < 8; ++i) vw[i] = pk2(vv[2 * i], vv[2 * i + 1]);
            u32x4* vd = (u32x4*)(VT + k * 72 + 16 * qd);
            vd[0] = (u32x4){vw[0], vw[1], vw[2], vw[3]}; vd[1] = (u32x4){vw[4], vw[5], vw[6], vw[7]};
        }
        __syncthreads();
        {
            const int nitem = item + gridDim.x;
            if (nitem < 1024) {
                const int nbh = nitem >> 5, nc = nitem & 31, nb = nbh >> 2, nh = nbh & 3;
                const bf16* zp = PROJ + (size_t)(nb * SEQ + nc * 64 + 16 * qd) * NPROJ + 2048 + nh * 128 + k;
#pragma unroll
                for (int i = 0; i < 16; ++i) { zi[i].x = zp[(size_t)i * NPROJ]; zi[i].y = zp[(size_t)i * NPROJ + 512]; if (i & 1) qq[i >> 1].y = zp[(size_t)i * NPROJ - 512]; else qq[i >> 1].x = zp[(size_t)i * NPROJ - 512]; }
            }
        }
        const int tt = wave & 3, vh = wave >> 2;
        bf16x8 sbf[4][4]; unsigned short gg[4][4];
        {
            const bf16* spb = SP + (size_t)item * 16384;
#pragma unroll
            for (int nt = 0; nt < 4; ++nt) {
                const int v = 16 * (4 * vh + nt) + fr;
#pragma unroll
                for (int ks = 0; ks < 4; ++ks) sbf[nt][ks] = *(const bf16x8*)(spb + (size_t)v * 128 + 32 * ks + 8 * fq);
#pragma unroll
                for (int j = 0; j < 4; ++j) gg[nt][j] = PROJ[(size_t)(t0 + 16 * tt + 4 * fq + j) * NPROJ + 3072 + h * 128 + v];
            }
        }
        for (int sb = wave; sb < 10; sb += 8) {
            const int I = (sb >= 6) ? 3 : (sb >= 3) ? 2 : (sb >= 1) ? 1 : 0; const int J = sb - (I * (I + 1)) / 2;
            f32x4 acc = {0.f, 0.f, 0.f, 0.f};
#pragma unroll
            for (int ks = 0; ks < 4; ++ks) {
                const int kb = 32 * ks + 8 * fq;
                const bf16x8 av = *(const bf16x8*)(Am + (16 * I + fr) * 136 + kb);
                u32x4 bw = *(const u32x4*)(Bm + (16 * J + fr) * 136 + kb);
                if (J != I - 1) {
                    f32x4 e0, e1;
                    if (J == I) { e0 = -*(const f32x4*)(part + I * 128 + kb); e1 = -*(const f32x4*)(part + I * 128 + kb + 4); }
                    else {
                        e0 = *(const f32x4*)(part + (J + 1) * 128 + kb); e1 = *(const f32x4*)(part + (J + 1) * 128 + kb + 4);
                        if (I - J == 3) { e0 += *(const f32x4*)(part + (J + 2) * 128 + kb); e1 += *(const f32x4*)(part + (J + 2) * 128 + kb + 4); }
                    }
#pragma unroll
                    for (int e = 0; e < 4; ++e) {
                        const float xl = (e < 2) ? e0[2 * e] : e1[2 * e - 4], xh = (e < 2) ? e0[2 * e + 1] : e1[2 * e - 3];
                        bw[e] = pk2(bflo(bw[e]) * __expf(fminf(xl, 80.f)), bfhi(bw[e]) * __expf(fminf(xh, 80.f)));
                    }
                }
                acc = MFMA16(av, __builtin_bit_cast(bf16x8, bw), acc);
            }
#pragma unroll
            for (int j = 0; j < 4; ++j) { const int t = 16 * I + 4 * fq + j, s = 16 * J + fr; P[t * 72 + s] = (bf16)f2bf((s <= t) ? acc[j] : 0.f); }
        }
        __syncthreads();
        f32x4 o[4];
        {
            bf16x8 aq[4], ap[2];
#pragma unroll
            for (int ks = 0; ks < 4; ++ks) aq[ks] = *(const bf16x8*)(Qg + (16 * tt + fr) * 136 + 32 * ks + 8 * fq);
#pragma unroll
            for (int ks = 0; ks < 2; ++ks) ap[ks] = *(const bf16x8*)(P + (16 * tt + fr) * 72 + 32 * ks + 8 * fq);
#pragma unroll
            for (int nt = 0; nt < 4; ++nt) {
                const int v = 16 * (4 * vh + nt) + fr;
                f32x4 acc = {0.f, 0.f, 0.f, 0.f};
#pragma unroll
                for (int ks = 0; ks < 4; ++ks) acc = MFMA16(aq[ks], sbf[nt][ks], acc);
#pragma unroll
                for (int ks = 0; ks < 2; ++ks) { const bf16x8 bb = *(const bf16x8*)(VT + v * 72 + 32 * ks + 8 * fq); acc = MFMA16(ap[ks], bb, acc); }
                o[nt] = acc;
            }
        }
        {
            float s4[4];
#pragma unroll
            for (int j = 0; j < 4; ++j) {
                float s = o[0][j] * o[0][j] + o[1][j] * o[1][j] + o[2][j] * o[2][j] + o[3][j] * o[3][j];
                s += __shfl_xor(s, 1); s += __shfl_xor(s, 2); s += __shfl_xor(s, 4); s += __shfl_xor(s, 8);
                s4[j] = s;
            }
            if (fr == 0) {
#pragma unroll
                for (int j = 0; j < 4; ++j) rowss[(16 * tt + 4 * fq + j) * 2 + vh] = s4[j];
            }
        }
        __syncthreads();
#pragma unroll
        for (int j = 0; j < 4; ++j) {
            const int t = 16 * tt + 4 * fq + j;
            const float rs = rsqrtf((rowss[t * 2] + rowss[t * 2 + 1]) * (1.f / 128.f) + RMS_EPS);
#pragma unroll
            for (int nt = 0; nt < 4; ++nt) {
                const int v = 16 * (4 * vh + nt) + fr;
                const float g = bf2f(gg[nt][j]);
                const float val = o[nt][j] * rs * p.hgrn_norm[v] * (g * sigmoidf_(g));
                MIX[(size_t)(t0 + t) * 1024 + 512 + h * 128 + v] = (bf16)f2bf(val);
            }
        }
        __syncthreads();
    }
}

__device__ __forceinline__ int crow(int reg, int hi) { return (reg & 3) + 8 * (reg >> 2) + 4 * hi; }
constexpr float LOG2E = 1.4426950408889634f;

typedef short v4i16_t __attribute__((ext_vector_type(4)));
__device__ __forceinline__ u32x2 vtr_read(const unsigned char* pl) {
    return __builtin_bit_cast(u32x2, __builtin_amdgcn_ds_read_tr16_b64_v4i16((PG8_LAS v4i16_t*)pl));
}

#define ATT3_ISSUE_LOADS(BH, D, R, N) do { _Pragma("unroll") for (int i = 0; i < 8; ++i) { \
        const int chunk = i * 256 + gt, row = chunk >> 3, ch = chunk & 7; \
        const int kidx = 128 * ((N) - 1) + row; \
        kv[i] = (u32x4){0u, 0u, 0u, 0u}; vv[i] = (u32x4){0u, 0u, 0u, 0u}; \
        if (kidx >= 0) { const size_t off = ((size_t)(BH) * 2048 + kidx * (D) + (R)) * 64 + ch * 8; kv[i] = *(const u32x4*)(K + off); vv[i] = *(const u32x4*)(V + off); } } } while (0)
__device__ __forceinline__ void att3_job(int gp, int grp, int& bh, int& br, int& d, int& r, int& n) {
    bh = gp / 24; const int job = 2 * (gp - bh * 24) + grp;
    if (job < 16) { br = 0; d = 1; r = 0; n = job; }
    else if (job < 32) { br = 1; d = 4; r = (job - 16) >> 2; n = (job - 16) & 3; }
    else { br = 2; d = 16; r = job - 32; n = 0; }
}
template <int FIRST> __device__ __forceinline__ void att3_tiles(const unsigned char* kbase, const unsigned char* vbase, const bf16x8 (&qf)[4], int c, int hi,
                                                                float& mrun, float& lsum, f32x16& o0, f32x16& o1) {
    f32x16 scn;
#pragma unroll
    for (int j = 0; j < 16; ++j) scn[j] = 0.f;
    {
        const unsigned char* kp = kbase + (32 * FIRST) * 144;
#pragma unroll
        for (int ks = 0; ks < 4; ++ks) { const bf16x8 kf = *(const bf16x8*)(kp + 32 * ks); scn = MFMA32(kf, qf[ks], scn); }
    }
#pragma unroll
    for (int i = FIRST; i < 5; ++i) {
        f32x16 sc = scn;
        if (i + 1 < 5) {
#pragma unroll
            for (int j = 0; j < 16; ++j) scn[j] = 0.f;
            const unsigned char* kp = kbase + (32 * (i + 1)) * 144;
#pragma unroll
            for (int ks = 0; ks < 4; ++ks) { const bf16x8 kf = *(const bf16x8*)(kp + 32 * ks); scn = MFMA32(kf, qf[ks], scn); }
        }
        if (i == 0) {
#pragma unroll
            for (int j = 0; j < 16; ++j) sc[j] = (crow(j, hi) >= c) ? sc[j] : -1e30f;
        }
        if (i == 4) {
#pragma unroll
            for (int j = 0; j < 16; ++j) sc[j] = (crow(j, hi) <= c) ? sc[j] : -1e30f;
        }
        float mx = sc[0];
#pragma unroll
        for (int j = 1; j < 16; ++j) mx = fmaxf(mx, sc[j]);
        mx = xor32_max(mx);
        const float mnew = fmaxf(mrun, mx);
        const float alpha = __builtin_amdgcn_exp2f((mrun - mnew) * LOG2E);
        const float mL = mnew * LOG2E;
        float rs = 0.f;
#pragma unroll
        for (int j = 0; j < 16; ++j) { const float pj = __builtin_amdgcn_exp2f(sc[j] * LOG2E - mL); sc[j] = pj; rs += pj; }
        rs = xor32_sum(rs);
        lsum = lsum * alpha + rs; mrun = mnew;
#pragma unroll
        for (int j = 0; j < 16; ++j) { o0[j] *= alpha; o1[j] *= alpha; }
        const unsigned char* vp = vbase + (32 * i) * 144;
#pragma unroll
        for (int ks = 0; ks < 2; ++ks) {
            u32x4 w; w.x = pk2(sc[8 * ks], sc[8 * ks + 1]); w.y = pk2(sc[8 * ks + 2], sc[8 * ks + 3]);
            w.z = pk2(sc[8 * ks + 4], sc[8 * ks + 5]); w.w = pk2(sc[8 * ks + 6], sc[8 * ks + 7]);
            const bf16x8 pb = __builtin_bit_cast(bf16x8, w);
            const u32x2 a00 = vtr_read(vp + (16 * ks) * 144), a01 = vtr_read(vp + (16 * ks + 8) * 144);
            const u32x2 a10 = vtr_read(vp + (16 * ks) * 144 + 64), a11 = vtr_read(vp + (16 * ks + 8) * 144 + 64);
            const u32x4 A0 = {a00.x, a00.y, a01.x, a01.y}, A1 = {a10.x, a10.y, a11.x, a11.y};
            o0 = MFMA32(__builtin_bit_cast(bf16x8, A0), pb, o0);
            o1 = MFMA32(__builtin_bit_cast(bf16x8, A1), pb, o1);
        }
    }
}
__device__ __forceinline__ void phase_attn3(const Params& p, unsigned char* smem) {
    const bf16* Q = (const bf16*)(p.ws + WS_BIG); const bf16* K = Q + (size_t)T_TOK * 1024; const bf16* V = K + (size_t)T_TOK * 1024;
    float* LSE = (float*)(p.ws + WS_LSE);
    const int tid = threadIdx.x, lane = tid & 63, wave = tid >> 6, c = lane & 31, hi = lane >> 5;
    const int grp = wave >> 2, w4 = wave & 3, gt = tid & 255;
    unsigned char* Kl = smem + grp * 73728; unsigned char* Vl = Kl + 36864;
    const int trl = 144 * ((lane & 15) >> 2) + 32 * ((lane >> 4) & 1) + 8 * (lane & 3) + 144 * 4 * hi;
    const int G = gridDim.x; const bool xcdmap = (G == 256);
    const int xcd = blockIdx.x & 7, li = blockIdx.x >> 3;
    const int cnt = xcdmap ? 12 : ((3072 - (int)blockIdx.x + G - 1) / G);
#define ATT3_GP(i) (xcdmap ? (xcd * 384 + li + 32 * (i)) : ((int)blockIdx.x + G * (i)))
    if (cnt <= 0) return;
    u32x4 kv[8], vv[8];
    int bh, br, d, r, n;
    att3_job(ATT3_GP(0), grp, bh, br, d, r, n);
    ATT3_ISSUE_LOADS(bh, d, r, n);
    for (int it = 0; it < cnt; ++it) {
        const int qi0 = 128 * n + 32 * w4, rowoff = 128 - 128 * n;
#pragma unroll
        for (int i = 0; i < 8; ++i) {
            const int chunk = i * 256 + gt, row = chunk >> 3, ch = chunk & 7;
            *(u32x4*)(Kl + row * 144 + ch * 16) = kv[i]; *(u32x4*)(Vl + row * 144 + ch * 16) = vv[i];
        }
        const int b = bh >> 4, h = bh & 15;
        const int tok = b * SEQ + (qi0 + c) * d + r;
        bf16x8 qf[4];
        {
            const bf16* qp = Q + ((size_t)bh * 2048 + (qi0 + c) * d + r) * 64 + 8 * hi;
#pragma unroll
            for (int ks = 0; ks < 4; ++ks) qf[ks] = *(const bf16x8*)(qp + 16 * ks);
        }
        const int cbr = br;
        __syncthreads();
        if (it + 1 < cnt) { att3_job(ATT3_GP(it + 1), grp, bh, br, d, r, n); ATT3_ISSUE_LOADS(bh, d, r, n); }
        float mrun = -1e30f, lsum = 0.f;
        f32x16 o0, o1;
#pragma unroll
        for (int j = 0; j < 16; ++j) { o0[j] = 0.f; o1[j] = 0.f; }
        {
            const int first = (qi0 >= 128) ? 0 : (4 - (qi0 >> 5));
            const unsigned char* kbase = Kl + (rowoff + qi0 - 128 + c) * 144 + 16 * hi;
            const unsigned char* vbase = Vl + (rowoff + qi0 - 128) * 144 + trl;
            switch (first) {
            case 0: att3_tiles<0>(kbase, vbase, qf, c, hi, mrun, lsum, o0, o1); break;
            case 1: att3_tiles<1>(kbase, vbase, qf, c, hi, mrun, lsum, o0, o1); break;
            case 2: att3_tiles<2>(kbase, vbase, qf, c, hi, mrun, lsum, o0, o1); break;
            case 3: att3_tiles<3>(kbase, vbase, qf, c, hi, mrun, lsum, o0, o1); break;
            default: att3_tiles<4>(kbase, vbase, qf, c, hi, mrun, lsum, o0, o1); break;
            }
        }
        {
            bf16* OB = (cbr == 2) ? (bf16*)(p.ws + WS_OB2) : ((bf16*)p.out + (size_t)cbr * ((size_t)T_TOK * 1024));
            const float inv = __builtin_amdgcn_rcpf(lsum);
            bf16* op = OB + (size_t)tok * 1024 + h * 64 + 4 * hi;
#pragma unroll
            for (int q = 0; q < 4; ++q) {
                u32x2 w0, w1;
                w0.x = pg8::cvt_pk_bf16(o0[4 * q] * inv, o0[4 * q + 1] * inv); w0.y = pg8::cvt_pk_bf16(o0[4 * q + 2] * inv, o0[4 * q + 3] * inv);
                w1.x = pg8::cvt_pk_bf16(o1[4 * q] * inv, o1[4 * q + 1] * inv); w1.y = pg8::cvt_pk_bf16(o1[4 * q + 2] * inv, o1[4 * q + 3] * inv);
                *(u32x2*)(op + 8 * q) = w0; *(u32x2*)(op + 32 + 8 * q) = w1;
            }
            if (hi == 0) LSE[(size_t)cbr * (T_TOK * 16) + (size_t)tok * 16 + h] = mrun * LOG2E + __builtin_amdgcn_logf(lsum);
        }
        __syncthreads();
    }
}
__device__ __forceinline__ void phase_attn_merge(const Params& p) {
    const bf16* O0 = (const bf16*)p.out; const bf16* O1 = O0 + (size_t)T_TOK * 1024; const bf16* O2 = (const bf16*)(p.ws + WS_OB2);
    const float* LSE = (const float*)(p.ws + WS_LSE); bf16* ATT = (bf16*)(p.ws + WS_MIX);
    const bool xcdmap = (gridDim.x == 256);
    const int total = T_TOK * 128;
    const int nthr = xcdmap ? 32 * 512 : (int)gridDim.x * 512;
    const int first = xcdmap ? ((int)(blockIdx.x >> 3) * 512 + (int)threadIdx.x) : ((int)blockIdx.x * 512 + (int)threadIdx.x);
    const int base = xcdmap ? (int)(blockIdx.x & 7) * (SEQ * 128) : 0;
    const int lim = xcdmap ? SEQ * 128 : total;
    for (int j = first; j < lim; j += nthr) {
        const int i = base + j;
        const int tok = i >> 7, c8 = (i & 127) * 8, h = c8 >> 6;
        const float l0 = LSE[(size_t)tok * 16 + h], l1 = LSE[(size_t)T_TOK * 16 + (size_t)tok * 16 + h], l2 = LSE[(size_t)2 * T_TOK * 16 + (size_t)tok * 16 + h];
        const float M = fmaxf(l0, fmaxf(l1, l2));
        const float e0 = __builtin_amdgcn_exp2f(l0 - M), e1 = __builtin_amdgcn_exp2f(l1 - M), e2 = __builtin_amdgcn_exp2f(l2 - M);
        const float isum = __builtin_amdgcn_rcpf(e0 + e1 + e2); const float w0 = e0 * isum, w1 = e1 * isum, w2 = e2 * isum;
        const size_t off = (size_t)tok * 1024 + c8;
        const u32x4 a = __builtin_nontemporal_load((const u32x4*)(O0 + off)), bq = __builtin_nontemporal_load((const u32x4*)(O1 + off)), cc = __builtin_nontemporal_load((const u32x4*)(O2 + off));
        u32x4 o;
#pragma unroll
        for (int q = 0; q < 4; ++q) o[q] = pk2(bflo(a[q]) * w0 + bflo(bq[q]) * w1 + bflo(cc[q]) * w2, bfhi(a[q]) * w0 + bfhi(bq[q]) * w1 + bfhi(cc[q]) * w2);
        *(u32x4*)(ATT + off) = o;
    }
}

__device__ __forceinline__ void phase_final(const Params& p) {
    const float* ss = (const float*)(p.ws + WS_SS) + 4 * T_TOK; const bf16* XB = (const bf16*)(p.ws + WS_XB);
    for (int i = blockIdx.x * 512 + threadIdx.x; i < T_TOK * 128; i += gridDim.x * 512) {
        const int row = i >> 7, c8 = (i & 127) * 8;
        const float r = rsqrtf(ss[row] * (1.f / 1024.f) + RMS_EPS);
        const u32x4 xv = __builtin_nontemporal_load((const u32x4*)(XB + (size_t)row * 1024 + c8));
        const f32x4 g0 = *(const f32x4*)(p.final_norm + c8), g1 = *(const f32x4*)(p.final_norm + c8 + 4);
        f32x4 o0 = {bflo(xv.x), bfhi(xv.x), bflo(xv.y), bfhi(xv.y)}, o1 = {bflo(xv.z), bfhi(xv.z), bflo(xv.w), bfhi(xv.w)};
        *(f32x4*)(p.out + (size_t)row * 1024 + c8) = o0 * r * g0; *(f32x4*)(p.out + (size_t)row * 1024 + c8 + 4) = o1 * r * g1;
    }
}

#define XB_TMO      128
#define XB_XCNT(j)  (256  + 64 * (j))
#define XB_XSUB(j)  (1280 + 64 * (j))
#define XB_XGEN(j)  (2304 + 64 * (j))
#define XB_TOP      3328
#define XB_TOPGEN   3392
#define XCD_BAR_WORDS 3456
#define XB_SPIN_CAP (1u << 18)

__device__ __forceinline__ unsigned xb_ld(unsigned* p)              { return __hip_atomic_load(p, __ATOMIC_RELAXED, __HIP_MEMORY_SCOPE_AGENT); }
__device__ __forceinline__ unsigned xb_add(unsigned* p, unsigned v) { return __hip_atomic_fetch_add(p, v, __ATOMIC_RELAXED, __HIP_MEMORY_SCOPE_AGENT); }
__device__ __forceinline__ unsigned xb_xcc_id() { return (unsigned)__builtin_amdgcn_s_getreg((3 << 11) | 20) & 0xFu; }
#define XB_SPIN(cond, bar) do { unsigned _sp = 0; while (cond) { __builtin_amdgcn_s_sleep(1); \
    if ((++_sp & 255u) == 0u) { if (xb_ld(&(bar)[XB_TMO])) break; if (_sp > XB_SPIN_CAP) { atomicAdd(&(bar)[XB_TMO], 1u); break; } } } } while (0)

struct XcdBarrier {
    unsigned* bar; unsigned x;
    volatile PG8_LAS unsigned* st;
};

__device__ __forceinline__ XcdBarrier xcd_barrier_post(unsigned* bar, volatile PG8_LAS unsigned* st) {
    XcdBarrier b; b.bar = bar; b.x = xb_xcc_id(); b.st = st;
    if (threadIdx.x == 0) (void)xb_add(&bar[XB_XCNT(b.x)], 1u);
    return b;
}
__device__ __forceinline__ void xcd_barrier_complete(unsigned* bar, unsigned x, unsigned& nloc, unsigned& nx) {
    const unsigned G = gridDim.x * gridDim.y * gridDim.z;
    unsigned sum, cnt, mine, sp = 0u;
    for (;;) {
        sum = 0u; cnt = 0u; mine = 0u;
#pragma unroll
        for (unsigned j = 0; j < 16; ++j) { const unsigned c = xb_ld(&bar[XB_XCNT(j)]); sum += c; cnt += (c > 0u) ? 1u : 0u; mine = (j == x) ? c : mine; }
        if (sum == G) break;
        __builtin_amdgcn_s_sleep(1);
        if ((++sp & 255u) == 0u) { if (xb_ld(&bar[XB_TMO])) break; if (sp > XB_SPIN_CAP) { atomicAdd(&bar[XB_TMO], 1u); break; } }
    }
    nloc = mine > 0u ? mine : 1u; nx = cnt > 0u ? cnt : 1u;
}

__device__ __forceinline__ void xcd_barrier(const XcdBarrier& b) {
    asm volatile("s_waitcnt vmcnt(0)" ::: "memory");
    __syncthreads();
    if (threadIdx.x == 0) {
        unsigned* bar = b.bar;
        __builtin_amdgcn_s_waitcnt(0);
        unsigned nloc = b.st[0], nx = b.st[1];
        if (nloc == 0u) { xcd_barrier_complete(bar, b.x, nloc, nx); b.st[0] = nloc; b.st[1] = nx; }
        const unsigned old = xb_add(&bar[XB_XSUB(b.x)], 1u);
        const unsigned gen = old / nloc;
        if (old + 1u == (gen + 1u) * nloc) {
            __builtin_amdgcn_fence(__ATOMIC_RELEASE, "agent");
            asm volatile("s_waitcnt vmcnt(0)" ::: "memory");
            const unsigned og = xb_add(&bar[XB_TOP], 1u);
            const unsigned tg = og / nx;
            if (og + 1u == (tg + 1u) * nx) xb_add(&bar[XB_TOPGEN], 1u);
            else XB_SPIN(xb_ld(&bar[XB_TOPGEN]) == tg, bar);
            __builtin_amdgcn_fence(__ATOMIC_ACQUIRE, "agent");
            xb_add(&bar[XB_XGEN(b.x)], 1u);
            asm volatile("s_waitcnt vmcnt(0)" ::: "memory");
        } else {
            XB_SPIN(xb_ld(&bar[XB_XGEN(b.x)]) == gen, bar);
            __builtin_amdgcn_fence(__ATOMIC_ACQUIRE, "agent");
            asm volatile("s_waitcnt vmcnt(0)" ::: "memory");
        }
    }
    __syncthreads();
}


constexpr int N_PHASES = 15;
#ifndef MK_CGSYNC
#define MK_CGSYNC 0
#endif
#ifndef PH_EN
#define PH_EN 0xfffff
#endif
#define EN(n) ((PH_EN >> (n)) & 1)
#ifndef REP_MASK
#define REP_MASK 0
#endif
#define REPS(n) (1 + ((REP_MASK >> (n)) & 1))
__global__ void __launch_bounds__(512, 2) mk_fwd(Params p, int ph_lo, int ph_hi) {
    extern __shared__ __attribute__((aligned(16))) unsigned char smem[];
    cg::grid_group grid = cg::this_grid();
    volatile PG8_LAS unsigned* xst = (volatile PG8_LAS unsigned*)((PG8_LAS unsigned char*)smem + LDS_MISC);
    if (threadIdx.x < 2) xst[threadIdx.x] = 0u;
    __syncthreads();
    XcdBarrier xbar = xcd_barrier_post((unsigned*)(p.ws + WS_BAR), xst);
#define IN(k) (EN(k) && ph_lo <= (k) && (k) < ph_hi)
#define SEAM(k) do { if ((k) + 1 < ph_hi) { if (MK_CGSYNC) grid.sync(); else xcd_barrier(xbar); } } while (0)
#define LDSP ((PG8_LAS unsigned char*)smem)
#define SSB ((float*)(p.ws + WS_SS))
#define WSB(off) ((bf16*)(p.ws + (off)))
    if (ph_hi > 1000) grid.sync();
    if (IN(0)) { for (int rep = 0; rep < REPS(0); ++rep) phase_prologue(p, smem); SEAM(0); }
    if (IN(1)) for (int rep = 0; rep < REPS(1); ++rep) {
        pg8::Gemm g{WSB(WS_XB), WSB(WS_W_INREC), T_TOK, NPROJ, DM}; pg8::StaticOrder S; S.init(T_TOK, NPROJ, gridDim.x, blockIdx.x);
        pg8::EpiScaleBf16 E{WSB(WS_BIG), NPROJ, SSB};
        pg8::gemm_phase<pg8::EpiScaleBf16, pg8::StaticOrder, true, true>(LDSP, g, S, E);
        {
            const int G = gridDim.x, rem = (64 * 14) % G;
            if (rem == 0) convert_items(p, smem, CONV_SPLIT, CONV_SPLIT2, blockIdx.x, G);
            else if ((int)blockIdx.x >= rem) convert_items(p, smem, CONV_SPLIT, CONV_SPLIT2, blockIdx.x - rem, G - rem);
        }
        SEAM(1);
    }
    if (IN(2)) { for (int rep = 0; rep < REPS(2); ++rep) { phase_conv(p); phase_hgrn_a(p, smem); } SEAM(2); }
    if (IN(3)) { for (int rep = 0; rep < REPS(3); ++rep) phase_hgrn_b(p); SEAM(3); }
    if (IN(4)) { for (int rep = 0; rep < REPS(4); ++rep) phase_hgrn_c(p, smem); SEAM(4); }
    if (IN(5)) {
        pg8::Gemm g{WSB(WS_MIX), WSB(WS_W_OUTREC), T_TOK, DM, DM}; pg8::StaticOrder S; S.init(T_TOK, DM, gridDim.x, blockIdx.x);
        pg8::EpiResid E{nullptr, WSB(WS_XB), WSB(WS_XB), SSB + 1 * T_TOK};
        pg8::gemm_phase<pg8::EpiResid, pg8::StaticOrder, true, true>(LDSP, g, S, E);
        SEAM(5);
    }
    if (IN(6)) for (int rep = 0; rep < REPS(6); ++rep) {
        pg8::Gemm g{WSB(WS_XB), WSB(WS_W_FFNIN0), T_TOK, 2 * DFF, DM}; pg8::StaticOrder S; S.init(T_TOK, 2 * DFF, gridDim.x, blockIdx.x);
        pg8::EpiSwiGLU E{WSB(WS_BIG), SSB + 1 * T_TOK};
        pg8::gemm_phase<pg8::EpiSwiGLU, pg8::StaticOrder, true, true>(LDSP, g, S, E);
        {
            const int G = gridDim.x, rem = (64 * 22) % G;
            if (rem == 0) convert_items(p, smem, CONV_SPLIT2, 1600, blockIdx.x, G);
            else if ((int)blockIdx.x >= rem) convert_items(p, smem, CONV_SPLIT2, 1600, blockIdx.x - rem, G - rem);
        }
        SEAM(6);
    }
    if (IN(7)) {
        pg8::Gemm g{WSB(WS_BIG), WSB(WS_W_FFNOUT0), T_TOK, DM, DFF}; pg8::StaticOrder S; S.init(T_TOK, DM, gridDim.x, blockIdx.x);
        pg8::EpiResid E{nullptr, WSB(WS_XB), WSB(WS_XB), SSB + 2 * T_TOK};
        pg8::gemm_phase<pg8::EpiResid, pg8::StaticOrder, true, true>(LDSP, g, S, E);
        SEAM(7);
    }
    if (IN(8)) {
        pg8::Gemm g{WSB(WS_XB), WSB(WS_W_QKV), T_TOK, 3 * DM, DM}; pg8::StaticOrder S; S.init(T_TOK, 3 * DM, gridDim.x, blockIdx.x);
        pg8::EpiQKV E{WSB(WS_BIG), SSB + 2 * T_TOK, (const float*)(p.ws + WS_ROPE)};
        pg8::gemm_phase<pg8::EpiQKV, pg8::StaticOrder, true, true>(LDSP, g, S, E);
        SEAM(8);
    }
    if (IN(9)) { for (int rep = 0; rep < REPS(9); ++rep) phase_attn3(p, smem); SEAM(9); }
    if (IN(10)) { phase_attn_merge(p); SEAM(10); }
    if (IN(11)) {
        pg8::Gemm g{WSB(WS_MIX), WSB(WS_W_O), T_TOK, DM, DM}; pg8::StaticOrder S; S.init(T_TOK, DM, gridDim.x, blockIdx.x);
        pg8::EpiResid E{nullptr, WSB(WS_XB), WSB(WS_XB), SSB + 3 * T_TOK};
        pg8::gemm_phase<pg8::EpiResid, pg8::StaticOrder, true, true>(LDSP, g, S, E);
        SEAM(11);
    }
    if (IN(12)) {
        pg8::Gemm g{WSB(WS_XB), WSB(WS_W_FFNIN1), T_TOK, 2 * DFF, DM}; pg8::StaticOrder S; S.init(T_TOK, 2 * DFF, gridDim.x, blockIdx.x);
        pg8::EpiSwiGLU E{WSB(WS_BIG), SSB + 3 * T_TOK};
        pg8::gemm_phase<pg8::EpiSwiGLU, pg8::StaticOrder, true, true>(LDSP, g, S, E);
        SEAM(12);
    }
    if (IN(13)) {
        pg8::Gemm g{WSB(WS_BIG), WSB(WS_W_FFNOUT1), T_TOK, DM, DFF}; pg8::StaticOrder S; S.init(T_TOK, DM, gridDim.x, blockIdx.x);
        pg8::EpiResid E{nullptr, WSB(WS_XB), WSB(WS_XB), SSB + 4 * T_TOK};
        pg8::gemm_phase<pg8::EpiResid, pg8::StaticOrder, true, true>(LDSP, g, S, E);
        SEAM(13);
    }
    if (IN(14)) { phase_final(p); }
}

extern "C" void kernel_launch(void* const* d_in, const int* in_sizes, int n_in, void* d_out, int out_size, void* d_ws, size_t ws_size, hipStream_t stream) {
    static int grid = 0;
    if (grid == 0) {
        if (n_in != 13 || in_sizes[0] != T_TOK * DM || out_size != T_TOK * DM || ws_size < WS_END) {
            fprintf(stderr, "kernel_launch: unexpected shapes (n_in %d, in0 %d, out %d, ws %zu)\n", n_in, n_in > 0 ? in_sizes[0] : -1, out_size, ws_size); grid = -1; return;
        }
        int dev = 0, cus = 0, per_cu = 0;
        hipGetDevice(&dev); hipDeviceGetAttribute(&cus, hipDeviceAttributeMultiprocessorCount, dev);
        if (hipFuncSetAttribute((const void*)mk_fwd, hipFuncAttributeMaxDynamicSharedMemorySize, LDS_BYTES) != hipSuccess) { fprintf(stderr, "kernel_launch: hipFuncSetAttribute failed\n"); grid = -1; return; }
        if (hipOccupancyMaxActiveBlocksPerMultiprocessor(&per_cu, (const void*)mk_fwd, 512, LDS_BYTES) != hipSuccess || per_cu < 1) { fprintf(stderr, "kernel_launch: occupancy query says %d\n", per_cu); per_cu = 1; (void)hipGetLastError(); }
        grid = cus * 1;
        if (per_cu < 1) grid = -1;
    }
    if (grid < 0) return;
    Params p{};
    p.x = (const float*)d_in[0]; p.mix_norm = (const float*)d_in[1]; p.ffn_norm = (const float*)d_in[2]; p.w_in_rec = (const float*)d_in[3]; p.conv_w = (const float*)d_in[4];
    p.hgrn_lb = (const float*)d_in[5]; p.hgrn_norm = (const float*)d_in[6]; p.w_out_rec = (const float*)d_in[7]; p.w_qkv = (const float*)d_in[8]; p.w_o = (const float*)d_in[9];
    p.w_ffn_in = (const float*)d_in[10]; p.w_ffn_out = (const float*)d_in[11]; p.final_norm = (const float*)d_in[12];
    p.out = (float*)d_out; p.ws = (unsigned char*)d_ws;
    if (hipMemsetAsync((char*)d_ws + WS_BAR, 0, 16384, stream) != hipSuccess) { fprintf(stderr, "kernel_launch: memset failed\n"); return; }
#if MK_SPLIT
    for (int ph = 0; ph < N_PHASES; ++ph) {
        hipLaunchKernelGGL(mk_fwd, dim3(grid), dim3(512), LDS_BYTES, stream, p, ph, ph + 1);
    }
#else
    int lo = 0, hi = N_PHASES;
    void* args[] = {&p, &lo, &hi};
    hipError_t e = hipLaunchCooperativeKernel((const void*)mk_fwd, dim3(grid), dim3(512), args, LDS_BYTES, stream);
    if (e != hipSuccess) fprintf(stderr, "kernel_launch: cooperative launch failed: %s (grid %d)\n", hipGetErrorString(e), grid);
#endif
}
```

```cpp
#include <hip/hip_runtime.h>
#include <hip/hip_cooperative_groups.h>
#include <cstdio>
#include <cstdint>
namespace cg = cooperative_groups;
#ifndef MK_SPLIT
#define MK_SPLIT 0
#endif
namespace pg8 {
#define PG8_LAS __attribute__((address_space(3)))
typedef unsigned short bf16_t;
typedef short bf16x8 __attribute__((ext_vector_type(8)));
typedef float f32x4 __attribute__((ext_vector_type(4)));
typedef unsigned u32x4 __attribute__((ext_vector_type(4)));
constexpr int BM = 256, BK = 64, HALF = 128, HTB = HALF * BK * 2  , STAGE_BYTES = 8 * HTB, NXCD = 8, WGM = 8;

__host__ __device__ __forceinline__ int lds_byte(int r, int c) { const int st = (r >> 4) * 2 + (c >> 5), rr = r & 15, cc = c & 31, ob = rr * 64 + cc * 2; return st * 1024 + (ob ^ (((ob >> 9) & 1) << 5)); }
__host__ __device__ __forceinline__ void stage_rc(int b, int& R, int& C) { const int st = b / 1024, sb = b % 1024, swz = sb ^ (((sb >> 9) & 1) << 5); R = (st >> 1) * 16 + swz / 64; C = (st & 1) * 32 + (swz % 64) / 2; }
__host__ __device__ __forceinline__ int perm32(int rho) { const int n = rho >> 4, i = rho & 15; return 8 * (i >> 2) + 4 * n + (i & 3); }

struct Unit { int pm, pn; };
struct Gemm { const bf16_t* A; const bf16_t* Bt; int M, N, K; };

struct StaticOrder {
    int nM, nN, nwg, G, c;
    __host__ __device__ void init(int M, int N, int G_, int c_) { nM = M / BM; nN = N / BM; nwg = nM * nN; G = G_; c = c_; }
    __host__ __device__ bool next(int i, Unit& u) const {
        const long L = (long)i * G + c; if (L >= nwg) return false;
        int wgid = (int)L; { const int q = nwg / NXCD, r = nwg % NXCD, xcd = wgid % NXCD, off = wgid / NXCD; wgid = (xcd < r ? xcd * (q + 1) : r * (q + 1) + (xcd - r) * q) + off; }
        const int nig = WGM * nN, gid = wgid / nig, fm = gid * WGM, gsz = (nM - fm) < WGM ? (nM - fm) : WGM;
        u.pm = fm + ((wgid % nig) % gsz); u.pn = (wgid % nig) / gsz; return true;
    }
    __device__ __forceinline__ void a_ready(const Unit&) const {}
    __device__ __forceinline__ void done(const Unit&) const {}
};
typedef float cvt_f32x2_t __attribute__((ext_vector_type(2))); typedef __bf16 cvt_bf16x2_t __attribute__((ext_vector_type(2)));
__device__ __forceinline__ unsigned cvt_pk_bf16(float lo, float hi) { cvt_f32x2_t v = {lo, hi}; cvt_bf16x2_t b = __builtin_convertvector(v, cvt_bf16x2_t); return __builtin_bit_cast(unsigned, b); }
typedef float f32x2 __attribute__((ext_vector_type(2)));

template <class Epi, class Sched, bool ALIGN_EPI = false, bool SP2 = false>
__device__ __forceinline__ void gemm_phase(PG8_LAS unsigned char* lds, const Gemm g, const Sched& S, const Epi& E) {
    const int tid = threadIdx.x, wid = __builtin_amdgcn_readfirstlane(tid >> 6), lane = tid & 63, wr = wid >> 2, wc = wid & 3, fr = lane & 15, fq = lane >> 4;
    const int K = g.K, nt = K / BK;
    unsigned voffA[2], voffB[2];
#pragma unroll
    for (int i = 0; i < 2; ++i) { int R, C; stage_rc(tid * 16 + i * 8192, R, C); const int Rb = Epi::PERM ? ((R & ~31) + perm32(R & 31)) : R;
        voffA[i] = (unsigned)(R * K + C) * 2u; voffB[i] = (unsigned)(Rb * K + C) * 2u; }
    const size_t kstep = (size_t)(BK * 2);
    const size_t hstep = (size_t)HALF * K * 2;
    const size_t tstep = 2 * hstep;
    const unsigned ldsw = (unsigned)wid * 1024u;
    const int aoff = lds_byte(wr * 64 + fr, fq * 8), boff = lds_byte(wc * 32 + fr, fq * 8);
#define PG8_SA(b, h) (((b) * 2 + (h)) * HTB)
#define PG8_SB(b, h) ((4 + (b) * 2 + (h)) * HTB)
#define PG8_STAGE(bufoff, gbase, voff) do { _Pragma("unroll") for (int _i = 0; _i < 2; ++_i) \
        __builtin_amdgcn_global_load_lds((const unsigned*)((const char*)(gbase) + (voff)[_i]), (PG8_LAS unsigned*)(lds + (bufoff) + ldsw + _i * 8192), 16, 0, 0); } while (0)
#define PG8_LDA(dst, b, h) do { _Pragma("unroll") for (int m = 0; m < 4; ++m) _Pragma("unroll") for (int k = 0; k < 2; ++k) dst[m][k] = *(const PG8_LAS bf16x8*)(lds + PG8_SA(b, h) + aoff + m * 2048 + k * 1024); } while (0)
#define PG8_LDB(dst, b, h) do { _Pragma("unroll") for (int n = 0; n < 2; ++n) _Pragma("unroll") for (int k = 0; k < 2; ++k) dst[n][k] = *(const PG8_LAS bf16x8*)(lds + PG8_SB(b, h) + boff + n * 2048 + k * 1024); } while (0)
#define PG8_MMA(ai, bj, At, Bt) do { __builtin_amdgcn_s_setprio(1); _Pragma("unroll") for (int m = 0; m < 4; ++m) _Pragma("unroll") for (int n = 0; n < 2; ++n) _Pragma("unroll") for (int k = 0; k < 2; ++k) \
        acc[ai][bj][m][n] = __builtin_amdgcn_mfma_f32_16x16x32_bf16(Bt[n][k], At[m][k], acc[ai][bj][m][n], 0, 0, 0); __builtin_amdgcn_s_setprio(0); } while (0)
#define PG8_WAIT_V(n) asm volatile("s_waitcnt vmcnt(" #n ")" ::: "memory")
#define PG8_WAIT_L(n) asm volatile("s_waitcnt lgkmcnt(" #n ")" ::: "memory")
#define PG8_BAR __builtin_amdgcn_s_barrier()
#define PG8_SCHED __builtin_amdgcn_sched_barrier(0)
    Unit cur, nxt; int ui = 0;
    if (!S.next(0, cur)) return;
    f32x4 acc[2][2][4][2];
#pragma unroll
    for (int a = 0; a < 2; ++a)
#pragma unroll
        for (int b = 0; b < 2; ++b)
#pragma unroll
            for (int m = 0; m < 4; ++m)
#pragma unroll
                for (int n = 0; n < 2; ++n) acc[a][b][m][n] = (f32x4){0.f, 0.f, 0.f, 0.f};
    bf16x8 At[4][2], B0[2][2], B1[2][2];
    const char* cA = (const char*)g.A + (size_t)cur.pm * tstep; const char* cB = (const char*)g.Bt + (size_t)cur.pn * tstep;
    S.a_ready(cur);
    typename Epi::Pre pre; E.prefetch(pre, cur, wr, fr); __builtin_amdgcn_sched_barrier(0);
    if constexpr (SP2) {
        PG8_STAGE(PG8_SB(0, 0), cB, voffB); PG8_STAGE(PG8_SB(0, 1), cB + hstep, voffB); PG8_STAGE(PG8_SA(0, 0), cA, voffA); PG8_STAGE(PG8_SA(0, 1), cA + hstep, voffA);
        if (wr == 1) PG8_BAR;
        PG8_WAIT_V(2); PG8_BAR;
        PG8_STAGE(PG8_SB(1, 0), cB + kstep, voffB); PG8_STAGE(PG8_SA(1, 0), cA + kstep, voffA); PG8_STAGE(PG8_SB(1, 1), cB + hstep + kstep, voffB);
        PG8_WAIT_V(6); PG8_BAR;
    } else {
        PG8_STAGE(PG8_SB(0, 0), cB, voffB); PG8_STAGE(PG8_SA(0, 0), cA, voffA); PG8_STAGE(PG8_SB(0, 1), cB + hstep, voffB); PG8_STAGE(PG8_SA(0, 1), cA + hstep, voffA);
        if (wr == 1) PG8_BAR;
        PG8_WAIT_V(4); PG8_BAR;
        PG8_STAGE(PG8_SB(1, 0), cB + kstep, voffB); PG8_STAGE(PG8_SA(1, 0), cA + kstep, voffA); PG8_STAGE(PG8_SB(1, 1), cB + hstep + kstep, voffB);
        PG8_WAIT_V(6); PG8_BAR;
    }
    for (;;) {
        const bool has_next = S.next(ui + 1, nxt);
        const char* nA = has_next ? (const char*)g.A + (size_t)nxt.pm * tstep : cA; const char* nB = has_next ? (const char*)g.Bt + (size_t)nxt.pn * tstep : cB;
        for (int t = 0; t < nt; t += 2) {
            const bool last = (t == nt - 2);
            const char* a1 = cA + (size_t)(t + 1) * kstep;
            const char* a2 = last ? nA : cA + (size_t)(t + 2) * kstep; const char* b2 = last ? nB : cB + (size_t)(t + 2) * kstep;
            const char* a3 = a2 + kstep; const char* b3 = b2 + kstep;
            if (last && has_next) S.a_ready(nxt);
            if constexpr (SP2) {
            PG8_LDB(B0, 0, 0); PG8_LDB(B1, 0, 1); PG8_SCHED; PG8_LDA(At, 0, 0); PG8_STAGE(PG8_SA(1, 1), a1 + hstep, voffA);
            PG8_WAIT_V(8); PG8_WAIT_L(0); PG8_BAR; PG8_MMA(0, 0, At, B0); PG8_MMA(0, 1, At, B1); PG8_BAR; PG8_SCHED;
            PG8_LDA(At, 0, 1); PG8_STAGE(PG8_SB(0, 0), b2, voffB); PG8_STAGE(PG8_SB(0, 1), b2 + hstep, voffB); PG8_STAGE(PG8_SA(0, 0), a2, voffA);
            PG8_WAIT_V(8); PG8_WAIT_L(0); PG8_BAR; PG8_MMA(1, 0, At, B0); PG8_MMA(1, 1, At, B1); PG8_BAR; PG8_SCHED;
            PG8_LDB(B0, 1, 0); PG8_LDB(B1, 1, 1); PG8_SCHED; PG8_LDA(At, 1, 0); PG8_STAGE(PG8_SA(0, 1), a2 + hstep, voffA);
            PG8_WAIT_V(8); PG8_WAIT_L(0); PG8_BAR; PG8_MMA(0, 0, At, B0); PG8_MMA(0, 1, At, B1); PG8_BAR; PG8_SCHED;
            PG8_LDA(At, 1, 1); PG8_STAGE(PG8_SB(1, 0), b3, voffB); PG8_STAGE(PG8_SB(1, 1), b3 + hstep, voffB); PG8_STAGE(PG8_SA(1, 0), a3, voffA);
            PG8_WAIT_V(8); PG8_WAIT_L(0); PG8_BAR; PG8_MMA(1, 0, At, B0); PG8_MMA(1, 1, At, B1); PG8_BAR; PG8_SCHED;
            } else {
            PG8_LDB(B0, 0, 0); PG8_SCHED; PG8_LDA(At, 0, 0); PG8_STAGE(PG8_SA(1, 1), a1 + hstep, voffA);
            PG8_WAIT_L(8); PG8_BAR; PG8_WAIT_L(0); PG8_MMA(0, 0, At, B0); PG8_BAR; PG8_SCHED;
            PG8_LDB(B1, 0, 1); PG8_STAGE(PG8_SB(0, 0), b2, voffB);
            PG8_BAR; PG8_WAIT_L(0); PG8_MMA(0, 1, At, B1); PG8_BAR;
            PG8_LDA(At, 0, 1); PG8_STAGE(PG8_SA(0, 0), a2, voffA);
            PG8_BAR; PG8_WAIT_L(0); PG8_MMA(1, 0, At, B0); PG8_BAR; PG8_SCHED;
            PG8_STAGE(PG8_SB(0, 1), b2 + hstep, voffB);
            PG8_WAIT_V(6); PG8_BAR; PG8_MMA(1, 1, At, B1); PG8_BAR;
            PG8_LDB(B0, 1, 0); PG8_SCHED; PG8_LDA(At, 1, 0); PG8_STAGE(PG8_SA(0, 1), a2 + hstep, voffA);
            PG8_WAIT_L(8); PG8_BAR; PG8_WAIT_L(0); PG8_MMA(0, 0, At, B0); PG8_BAR; PG8_SCHED;
            PG8_LDB(B1, 1, 1); PG8_STAGE(PG8_SB(1, 0), b3, voffB);
            PG8_BAR; PG8_WAIT_L(0); PG8_MMA(0, 1, At, B1); PG8_BAR;
            PG8_LDA(At, 1, 1); PG8_STAGE(PG8_SA(1, 0), a3, voffA);
            PG8_BAR; PG8_WAIT_L(0); PG8_MMA(1, 0, At, B0); PG8_BAR; PG8_SCHED;
            PG8_STAGE(PG8_SB(1, 1), b3 + hstep, voffB);
            PG8_WAIT_V(6); PG8_BAR; PG8_MMA(1, 1, At, B1); PG8_BAR;
            }
        }
        if constexpr (ALIGN_EPI) { if (wr == 0) PG8_BAR; }
        if constexpr (!Epi::AFTER_DRAIN) { E(acc, cur, wr, wc, fr, fq, pre); S.done(cur); }
        if (!has_next) break;
#pragma unroll
        for (int a = 0; a < 2; ++a)
#pragma unroll
            for (int b = 0; b < 2; ++b)
#pragma unroll
                for (int m = 0; m < 4; ++m)
#pragma unroll
                    for (int n = 0; n < 2; ++n) acc[a][b][m][n] = (f32x4){0.f, 0.f, 0.f, 0.f};
        cur = nxt; cA = nA; cB = nB; ++ui;
        E.prefetch(pre, cur, wr, fr); __builtin_amdgcn_sched_barrier(0);
        if constexpr (ALIGN_EPI) { if (wr == 1) PG8_BAR; }
    }
    PG8_WAIT_V(0);
    if constexpr (!ALIGN_EPI) { if (wr == 0) PG8_BAR; }
    PG8_BAR;
    if constexpr (Epi::AFTER_DRAIN) { E.fused(acc, cur, wr, wc, fr, fq, lds, wid, lane); S.done(cur); }
#undef PG8_SA
#undef PG8_SB
#undef PG8_STAGE
#undef PG8_LDA
#undef PG8_LDB
#undef PG8_MMA
#undef PG8_WAIT_V
#undef PG8_WAIT_L
#undef PG8_BAR
#undef PG8_SCHED
}
}

constexpr int T_TOK = 16384, SEQ = 2048, DM = 1024, DFF = 2816, NPROJ = 3584;
constexpr float RMS_EPS = 1e-6f;
constexpr size_t MiB = 1u << 20;
constexpr size_t WS_SS = 0;
constexpr size_t WS_DEC = 512 * 1024;
constexpr size_t WS_ROPE = 1 * MiB;
constexpr size_t WS_W_INREC = 2 * MiB, WS_W_OUTREC = 9 * MiB, WS_W_QKV = 11 * MiB, WS_W_O = 17 * MiB;
constexpr size_t WS_W_FFNIN0 = 19 * MiB, WS_W_FFNIN1 = 30 * MiB, WS_W_FFNOUT0 = 41 * MiB, WS_W_FFNOUT1 = 46 * MiB + 512 * 1024;
constexpr size_t WS_XB = 52 * MiB;
constexpr size_t WS_MIX = 84 * MiB;
constexpr size_t WS_BIG = 116 * MiB;
constexpr size_t WS_OB2 = 212 * MiB;
constexpr size_t WS_LSE = 244 * MiB;
constexpr size_t WS_END = 247 * MiB;
constexpr int LDS_BYTES = 147456 + 256;
constexpr int LDS_MISC = 147456;
constexpr size_t WS_BAR = 384 * 1024;

typedef unsigned short bf16;
using pg8::bf16x8; using pg8::f32x4; using pg8::u32x4;
typedef float f32x16 __attribute__((ext_vector_type(16)));
typedef unsigned u32x2 __attribute__((ext_vector_type(2)));

struct Params {
    const float *x, *mix_norm, *ffn_norm, *w_in_rec, *conv_w, *hgrn_lb, *hgrn_norm, *w_out_rec, *w_qkv, *w_o, *w_ffn_in, *w_ffn_out, *final_norm;
    float* out; unsigned char* ws;
};

typedef float f32x2_t __attribute__((ext_vector_type(2)));
typedef __bf16 bf16x2_t __attribute__((ext_vector_type(2)));
__device__ __forceinline__ unsigned pk2(float lo, float hi) { f32x2_t v = {lo, hi}; bf16x2_t b = __builtin_convertvector(v, bf16x2_t); return __builtin_bit_cast(unsigned, b); }
__device__ __forceinline__ unsigned f2bf(float f) { return pk2(f, 0.f) & 0xffffu; }
__device__ __forceinline__ float bf2f(unsigned short b) { return __builtin_bit_cast(float, (unsigned)b << 16); }
__device__ __forceinline__ float bflo(unsigned u) { return __builtin_bit_cast(float, u << 16); }
__device__ __forceinline__ float bfhi(unsigned u) { return __builtin_bit_cast(float, u & 0xffff0000u); }
__device__ __forceinline__ float wave_sum(float v) {
#pragma unroll
    for (int o = 1; o < 64; o <<= 1) v += __shfl_xor(v, o);
    return v;
}
__device__ __forceinline__ float xor32_max(float x) { const unsigned xi = __builtin_bit_cast(unsigned, x); auto r = __builtin_amdgcn_permlane32_swap(xi, xi, false, false); return fmaxf(__builtin_bit_cast(float, (unsigned)r[0]), __builtin_bit_cast(float, (unsigned)r[1])); }
__device__ __forceinline__ float xor32_sum(float x) { const unsigned xi = __builtin_bit_cast(unsigned, x); auto r = __builtin_amdgcn_permlane32_swap(xi, xi, false, false); return __builtin_bit_cast(float, (unsigned)r[0]) + __builtin_bit_cast(float, (unsigned)r[1]); }
__device__ __forceinline__ float sigmoidf_(float z) { return __builtin_amdgcn_rcpf(1.f + __expf(-z)); }

namespace pg8 {
#ifndef MK_WT_STORES
#define MK_WT_STORES 1
#endif
__device__ __forceinline__ void st16(void* p, u32x4 v) {
#if MK_WT_STORES
    asm volatile("global_store_dwordx4 %0, %1, off sc1\n\ts_nop 1" :: "v"(p), "v"(v) : "memory");
#else
    *(u32x4*)p = v;
#endif
}
struct EpiScaleBf16 {
    static constexpr bool PERM = true, AFTER_DRAIN = false;
    bf16_t* O; int ldc; const float* ss;
    struct Pre { float ssv[2][4]; };
    __device__ __forceinline__ void prefetch(Pre& pre, const Unit& u, int wr, int fr) const {
#pragma unroll
        for (int ai = 0; ai < 2; ++ai)
#pragma unroll
            for (int m = 0; m < 4; ++m) pre.ssv[ai][m] = ss[u.pm * BM + wr * 64 + fr + ai * HALF + m * 16];
    }
    __device__ __forceinline__ void operator()(const f32x4 (&acc)[2][2][4][2], const Unit& u, int wr, int wc, int fr, int fq, const Pre& pre) const {
        const int row0 = u.pm * BM + wr * 64 + fr, col0 = u.pn * BM + wc * 32 + 8 * fq;
#pragma unroll
        for (int ai = 0; ai < 2; ++ai)
#pragma unroll
            for (int m = 0; m < 4; ++m) {
                const int row = row0 + ai * HALF + m * 16;
                const float r = rsqrtf(pre.ssv[ai][m] * (1.f / 1024.f) + 1e-6f);
                bf16_t* rowp = O + (size_t)row * ldc + col0;
#pragma unroll
                for (int bj = 0; bj < 2; ++bj) {
                    const f32x4 v0 = acc[ai][bj][m][0] * r, v1 = acc[ai][bj][m][1] * r;
                    u32x4 w; w.x = cvt_pk_bf16(v0[0], v0[1]); w.y = cvt_pk_bf16(v0[2], v0[3]); w.z = cvt_pk_bf16(v1[0], v1[1]); w.w = cvt_pk_bf16(v1[2], v1[3]);
                    st16(rowp + bj * HALF, w);
                }
            }
    }
};
struct EpiSwiGLU {
    static constexpr bool PERM = true, AFTER_DRAIN = false;
    bf16_t* H; const float* ss;
    struct Pre { float ssv[2][4]; };
    __device__ __forceinline__ void prefetch(Pre& pre, const Unit& u, int wr, int fr) const {
#pragma unroll
        for (int ai = 0; ai < 2; ++ai)
#pragma unroll
            for (int m = 0; m < 4; ++m) pre.ssv[ai][m] = ss[u.pm * BM + wr * 64 + fr + ai * HALF + m * 16];
    }
    __device__ __forceinline__ void operator()(const f32x4 (&acc)[2][2][4][2], const Unit& u, int wr, int wc, int fr, int fq, const Pre& pre) const {
        const int row0 = u.pm * BM + wr * 64 + fr, col0 = u.pn * HALF + wc * 32 + 8 * fq;
#pragma unroll
        for (int ai = 0; ai < 2; ++ai)
#pragma unroll
            for (int m = 0; m < 4; ++m) {
                const int row = row0 + ai * HALF + m * 16;
                const float r = rsqrtf(pre.ssv[ai][m] * (1.f / 1024.f) + 1e-6f);
                float o[8];
#pragma unroll
                for (int n = 0; n < 2; ++n)
#pragma unroll
                    for (int j = 0; j < 4; ++j) {
                        const float g = acc[ai][0][m][n][j] * r, up = acc[ai][1][m][n][j] * r;
                        o[4 * n + j] = g * up * __builtin_amdgcn_rcpf(1.f + __expf(-g));
                    }
                u32x4 w; w.x = cvt_pk_bf16(o[0], o[1]); w.y = cvt_pk_bf16(o[2], o[3]); w.z = cvt_pk_bf16(o[4], o[5]); w.w = cvt_pk_bf16(o[6], o[7]);
                st16(H + (size_t)row * 2816 + col0, w);
            }
    }
};
struct EpiQKV {
    static constexpr bool PERM = true, AFTER_DRAIN = false;
    bf16_t* QKV; const float* ss; const float* rope;
    struct Pre { float ssv[2][4]; };
    __device__ __forceinline__ void prefetch(Pre& pre, const Unit& u, int wr, int fr) const {
#pragma unroll
        for (int ai = 0; ai < 2; ++ai)
#pragma unroll
            for (int m = 0; m < 4; ++m) pre.ssv[ai][m] = ss[u.pm * BM + wr * 64 + fr + ai * HALF + m * 16];
    }
    __device__ __forceinline__ void operator()(const f32x4 (&acc)[2][2][4][2], const Unit& u, int wr, int wc, int fr, int fq, const Pre& pre) const {
        const int row0 = u.pm * BM + wr * 64 + fr;
        const int t = u.pn >> 2, head = 4 * (u.pn & 3) + wc;
        bf16_t* base = QKV + (size_t)t * ((size_t)16384 * 1024) + (size_t)head * (2048 * 64) + 8 * fq;
        const float qs = (t == 0) ? 0.125f : 1.f;
#pragma unroll
        for (int ai = 0; ai < 2; ++ai)
#pragma unroll
            for (int m = 0; m < 4; ++m) {
                const int row = row0 + ai * HALF + m * 16;
                const float r = rsqrtf(pre.ssv[ai][m] * (1.f / 1024.f) + 1e-6f) * qs;
                float y1[8], y2[8];
                if (t < 2) {
                    const float* cs = rope + (size_t)(row & 2047) * 64 + 8 * fq;
                    const f32x4 c0 = *(const f32x4*)(cs), c1 = *(const f32x4*)(cs + 4), s0 = *(const f32x4*)(cs + 32), s1 = *(const f32x4*)(cs + 36);
#pragma unroll
                    for (int j = 0; j < 4; ++j) {
                        const float a0 = acc[ai][0][m][0][j] * r, b0 = acc[ai][1][m][0][j] * r, a1 = acc[ai][0][m][1][j] * r, b1 = acc[ai][1][m][1][j] * r;
                        y1[j] = a0 * c0[j] - b0 * s0[j]; y2[j] = a0 * s0[j] + b0 * c0[j];
                        y1[4 + j] = a1 * c1[j] - b1 * s1[j]; y2[4 + j] = a1 * s1[j] + b1 * c1[j];
                    }
                } else {
#pragma unroll
                    for (int j = 0; j < 4; ++j) { y1[j] = acc[ai][0][m][0][j] * r; y2[j] = acc[ai][1][m][0][j] * r; y1[4 + j] = acc[ai][0][m][1][j] * r; y2[4 + j] = acc[ai][1][m][1][j] * r; }
                }
                u32x4 w1, w2;
                w1.x = cvt_pk_bf16(y1[0], y1[1]); w1.y = cvt_pk_bf16(y1[2], y1[3]); w1.z = cvt_pk_bf16(y1[4], y1[5]); w1.w = cvt_pk_bf16(y1[6], y1[7]);
                w2.x = cvt_pk_bf16(y2[0], y2[1]); w2.y = cvt_pk_bf16(y2[2], y2[3]); w2.z = cvt_pk_bf16(y2[4], y2[5]); w2.w = cvt_pk_bf16(y2[6], y2[7]);
                bf16_t* rp = base + (size_t)(row >> 11) * (16 * 2048 * 64) + (size_t)(row & 2047) * 64;
                st16(rp, w1); st16(rp + 32, w2);
            }
    }
};
struct EpiResid {
    static constexpr bool PERM = true, AFTER_DRAIN = false;
    const float* x32; const bf16_t* xb; bf16_t* XB; float* ssout;
    struct Pre {};
    __device__ __forceinline__ void prefetch(Pre&, const Unit&, int, int) const {}
    __device__ __forceinline__ void operator()(const f32x4 (&acc)[2][2][4][2], const Unit& u, int wr, int wc, int fr, int fq, const Pre& pre) const {
        const int row0 = u.pm * BM + wr * 64 + fr, col0 = u.pn * BM + wc * 32 + 8 * fq;
        float srow[2][4];
#pragma unroll
        for (int ai = 0; ai < 2; ++ai) {
            f32x4 xr[4][2][2];
            if (x32) {
#pragma unroll
                for (int m = 0; m < 4; ++m)
#pragma unroll
                    for (int bj = 0; bj < 2; ++bj) { const float* px = x32 + (size_t)(row0 + ai * HALF + m * 16) * 1024 + col0 + bj * HALF; xr[m][bj][0] = *(const f32x4*)(px); xr[m][bj][1] = *(const f32x4*)(px + 4); }
            } else {
                u32x4 xv[4][2];
#pragma unroll
                for (int m = 0; m < 4; ++m)
#pragma unroll
                    for (int bj = 0; bj < 2; ++bj) xv[m][bj] = *(const u32x4*)(xb + (size_t)(row0 + ai * HALF + m * 16) * 1024 + col0 + bj * HALF);
#pragma unroll
                for (int m = 0; m < 4; ++m)
#pragma unroll
                    for (int bj = 0; bj < 2; ++bj) {
                        const u32x4 v = xv[m][bj];
                        xr[m][bj][0] = (f32x4){__builtin_bit_cast(float, v.x << 16), __builtin_bit_cast(float, v.x & 0xffff0000u), __builtin_bit_cast(float, v.y << 16), __builtin_bit_cast(float, v.y & 0xffff0000u)};
                        xr[m][bj][1] = (f32x4){__builtin_bit_cast(float, v.z << 16), __builtin_bit_cast(float, v.z & 0xffff0000u), __builtin_bit_cast(float, v.w << 16), __builtin_bit_cast(float, v.w & 0xffff0000u)};
                    }
            }
#pragma unroll
            for (int m = 0; m < 4; ++m) {
                const size_t off = (size_t)(row0 + ai * HALF + m * 16) * 1024 + col0;
                float s = 0.f;
#pragma unroll
                for (int bj = 0; bj < 2; ++bj) {
                    const f32x4 v0 = acc[ai][bj][m][0] + xr[m][bj][0], v1 = acc[ai][bj][m][1] + xr[m][bj][1];
                    u32x4 w; w.x = cvt_pk_bf16(v0[0], v0[1]); w.y = cvt_pk_bf16(v0[2], v0[3]); w.z = cvt_pk_bf16(v1[0], v1[1]); w.w = cvt_pk_bf16(v1[2], v1[3]);
                    st16(XB + off + bj * HALF, w);
                    const float r0 = __builtin_bit_cast(float, w.x << 16), r1 = __builtin_bit_cast(float, w.x & 0xffff0000u), r2 = __builtin_bit_cast(float, w.y << 16), r3 = __builtin_bit_cast(float, w.y & 0xffff0000u);
                    const float r4 = __builtin_bit_cast(float, w.z << 16), r5 = __builtin_bit_cast(float, w.z & 0xffff0000u), r6 = __builtin_bit_cast(float, w.w << 16), r7 = __builtin_bit_cast(float, w.w & 0xffff0000u);
                    s += (r0 * r0 + r1 * r1) + (r2 * r2 + r3 * r3) + (r4 * r4 + r5 * r5) + (r6 * r6 + r7 * r7);
                }
                srow[ai][m] = s;
            }
        }
#pragma unroll
        for (int ai = 0; ai < 2; ++ai)
#pragma unroll
            for (int m = 0; m < 4; ++m) srow[ai][m] += __shfl_xor(srow[ai][m], 16);
#pragma unroll
        for (int ai = 0; ai < 2; ++ai)
#pragma unroll
            for (int m = 0; m < 4; ++m) srow[ai][m] += __shfl_xor(srow[ai][m], 32);
        if (fq == 0) {
#pragma unroll
            for (int ai = 0; ai < 2; ++ai)
#pragma unroll
                for (int m = 0; m < 4; ++m) atomicAdd(ssout + row0 + ai * HALF + m * 16, srow[ai][m]);
        }
    }
};
}

__device__ __forceinline__ int src_col(int kind, int n) {
    if (kind == 0) return n;
    const int pn = n >> 8, bj = (n >> 7) & 1, c = n & 127;
    if (kind == 1) return bj * 2816 + 128 * pn + c;
    const int t = pn >> 2, head = 4 * (pn & 3) + (c >> 5), i = c & 31;
    return t * 1024 + head * 64 + bj * 32 + i;
}
__device__ __forceinline__ void convert_tile(const float* __restrict__ W, bf16* __restrict__ Bt, int K, int N, const float* __restrict__ gain, int kind, int tile, float* Tl) {
    const int ntn = N >> 8; const int kt = tile / ntn, nt = tile - kt * ntn; const int k0 = kt * 64, n0 = nt * 256;
    const int tid = threadIdx.x;
    {
        f32x4 v[8];
        const int n4 = (tid & 63) * 4; const int sc = src_col(kind, n0 + n4);
#pragma unroll
        for (int i = 0; i < 8; ++i) { const int kk = i * 8 + (tid >> 6); v[i] = __builtin_nontemporal_load((const f32x4*)(W + (size_t)(k0 + kk) * N + sc)); }
        if (gain) {
#pragma unroll
            for (int i = 0; i < 8; ++i) v[i] = v[i] * gain[k0 + i * 8 + (tid >> 6)];
        }
#pragma unroll
        for (int i = 0; i < 8; ++i) { const int kk = i * 8 + (tid >> 6); *(f32x4*)(Tl + kk * 260 + n4) = v[i]; }
    }
    __syncthreads();
    {
        const int n = tid & 255, chalf = tid >> 8;
#pragma unroll
        for (int i = 0; i < 4; ++i) {
            const int c = 2 * i + chalf; const float* sp = Tl + (8 * c) * 260 + n;
            u32x4 o; o.x = pg8::cvt_pk_bf16(sp[0], sp[260]); o.y = pg8::cvt_pk_bf16(sp[520], sp[780]); o.z = pg8::cvt_pk_bf16(sp[1040], sp[1300]); o.w = pg8::cvt_pk_bf16(sp[1560], sp[1820]);
            *(u32x4*)(Bt + (size_t)(n0 + n) * K + k0 + 8 * c) = o;
        }
    }
    __syncthreads();
}

__device__ __forceinline__ void convert_items(const Params& p, unsigned char* smem, int lo, int hi, int first, int stride) {
    float* Tl = (float*)smem;
    for (int item = lo + first; item < hi; item += stride) {
        int t = item; const float* W; bf16* Bt; int K, N, kind; const float* gain;
        if (t < 224) { W = p.w_in_rec; Bt = (bf16*)(p.ws + WS_W_INREC); K = 1024; N = 3584; kind = 0; gain = p.mix_norm; }
        else if ((t -= 224) < 64) { W = p.w_out_rec; Bt = (bf16*)(p.ws + WS_W_OUTREC); K = 1024; N = 1024; kind = 0; gain = nullptr; }
        else if ((t -= 64) < 352) { W = p.w_ffn_in; Bt = (bf16*)(p.ws + WS_W_FFNIN0); K = 1024; N = 5632; kind = 1; gain = p.ffn_norm; }
        else if ((t -= 352) < 176) { W = p.w_ffn_out; Bt = (bf16*)(p.ws + WS_W_FFNOUT0); K = 2816; N = 1024; kind = 0; gain = nullptr; }
        else if ((t -= 176) < 192) { W = p.w_qkv; Bt = (bf16*)(p.ws + WS_W_QKV); K = 1024; N = 3072; kind = 2; gain = p.mix_norm + 1024; }
        else if ((t -= 192) < 64) { W = p.w_o; Bt = (bf16*)(p.ws + WS_W_O); K = 1024; N = 1024; kind = 0; gain = nullptr; }
        else if ((t -= 64) < 352) { W = p.w_ffn_in + (size_t)1024 * 5632; Bt = (bf16*)(p.ws + WS_W_FFNIN1); K = 1024; N = 5632; kind = 1; gain = p.ffn_norm + 1024; }
        else { t -= 352; W = p.w_ffn_out + (size_t)2816 * 1024; Bt = (bf16*)(p.ws + WS_W_FFNOUT1); K = 2816; N = 1024; kind = 0; gain = nullptr; }
        convert_tile(W, Bt, K, N, gain, kind, t, Tl);
    }
}
#ifndef CONV_SPLIT2
#define CONV_SPLIT2 816
#endif
#ifndef CONV_SPLIT
#define CONV_SPLIT 224
#endif

__device__ __forceinline__ void phase_prologue(const Params& p, unsigned char* smem) {
    const int tid = threadIdx.x, lane = tid & 63, wave = tid >> 6;
    convert_items(p, smem, 0, CONV_SPLIT, blockIdx.x, gridDim.x);
    {
        float* ss = (float*)(p.ws + WS_SS); bf16* XB = (bf16*)(p.ws + WS_XB);
        for (int row = blockIdx.x * 8 + wave; row < T_TOK; row += gridDim.x * 8) {
            const f32x4* xr = (const f32x4*)(p.x + (size_t)row * 1024) + lane;
            f32x4 v[4]; float s = 0.f;
#pragma unroll
            for (int j = 0; j < 4; ++j) { v[j] = __builtin_nontemporal_load(xr + 64 * j); s += (v[j][0] * v[j][0] + v[j][1] * v[j][1]) + (v[j][2] * v[j][2] + v[j][3] * v[j][3]); }
            s = wave_sum(s);
            u32x2* o = (u32x2*)(XB + (size_t)row * 1024) + lane;
#pragma unroll
            for (int j = 0; j < 4; ++j) { u32x2 w; w.x = pk2(v[j][0], v[j][1]); w.y = pk2(v[j][2], v[j][3]); o[64 * j] = w; }
            if (lane == 0) ss[row] = s;
        }
        for (int i = blockIdx.x * 512 + tid; i < 4 * T_TOK; i += gridDim.x * 512) ss[T_TOK + i] = 0.f;
    }
    {
        float* rope = (float*)(p.ws + WS_ROPE);
        for (int i = blockIdx.x * 512 + tid; i < SEQ * 32; i += gridDim.x * 512) {
            const int pos = i >> 5, f = i & 31;
            const float freq = exp2f(-(float)f * (13.287712379549449f / 32.f));
            const float ang = (float)pos * freq;
            const double a = (double)ang; const double kq = rint(a * 0.15915494309189535); const float r = (float)(a - kq * 6.283185307179586);
            rope[pos * 64 + f] = __cosf(r); rope[pos * 64 + 32 + f] = __sinf(r);
        }
    }
}

__device__ __forceinline__ float hgrn_lb_of(const Params& p, int ch) {
    const float a = p.hgrn_lb[ch], b = p.hgrn_lb[512 + ch], c = p.hgrn_lb[1024 + ch];
    const float m = fmaxf(a, fmaxf(b, c)); const float ea = __expf(a - m), eb = __expf(b - m), ec = __expf(c - m);
    return eb * __builtin_amdgcn_rcpf(ea + eb + ec);
}

__device__ __forceinline__ void phase_conv(const Params& p) {
    const bf16* PROJ = (const bf16*)(p.ws + WS_BIG); bf16* MIX = (bf16*)(p.ws + WS_MIX);
    const int tid = threadIdx.x;
    for (int task = blockIdx.x * 512 + tid; task < T_TOK * 64; task += gridDim.x * 512) {
        const int tok = task >> 6, c8 = (task & 63) * 8; const int pos = tok & (SEQ - 1);
        const bf16* row = PROJ + (size_t)tok * NPROJ + c8;
        const u32x4 bg = __builtin_nontemporal_load((const u32x4*)(row));
        float y[8];
#pragma unroll
        for (int e = 0; e < 8; ++e) y[e] = 0.f;
#pragma unroll
        for (int j = 0; j < 3; ++j) {
            const int back = 2 - j;
            if (pos >= back) {
                const bf16* rj = row - (size_t)back * NPROJ;
                const u32x4 cgv = *(const u32x4*)(rj + 512), vcv = *(const u32x4*)(rj + 1024);
                const f32x4 w0 = *(const f32x4*)(p.conv_w + j * 512 + c8), w1 = *(const f32x4*)(p.conv_w + j * 512 + c8 + 4);
#pragma unroll
                for (int q = 0; q < 4; ++q) {
                    const float wl = (q < 2) ? w0[2 * q] : w1[2 * q - 4], wh = (q < 2) ? w0[2 * q + 1] : w1[2 * q - 3];
                    y[2 * q] += wl * bflo(cgv[q]) * bflo(vcv[q]);
                    y[2 * q + 1] += wh * bfhi(cgv[q]) * bfhi(vcv[q]);
                }
            }
        }
        u32x4 o;
#pragma unroll
        for (int q = 0; q < 4; ++q) o[q] = pk2(y[2 * q] * bflo(bg[q]), y[2 * q + 1] * bfhi(bg[q]));
        *(u32x4*)(MIX + (size_t)tok * 1024 + c8) = o;
    }
}

#define MFMA16(a, b, c) __builtin_amdgcn_mfma_f32_16x16x32_bf16((a), (b), (c), 0, 0, 0)
#define MFMA32(a, b, c) __builtin_amdgcn_mfma_f32_32x32x16_bf16((a), (b), (c), 0, 0, 0)

__device__ __forceinline__ void phase_hgrn_a(const Params& p, unsigned char* smem) {
    const bf16* PROJ = (const bf16*)(p.ws + WS_BIG); bf16* UT = (bf16*)p.out; float* DEC = (float*)(p.ws + WS_DEC);
    bf16* KgT = (bf16*)smem;
    bf16* VT = KgT + 128 * 72;
    float* part = (float*)(smem + 2 * 128 * 72 * 2);
    const int tid = threadIdx.x, lane = tid & 63, wave = tid >> 6, fr = lane & 15, fq = lane >> 4;
    const int k = tid & 127, qd = tid >> 7;
    for (int item = blockIdx.x; item < 1024; item += gridDim.x) {
        const int bh = item >> 5, c = item & 31, b = bh >> 2, h = bh & 3;
        const int t0 = b * SEQ + c * 64;
        const float lb = hgrn_lb_of(p, h * 128 + k);
        const bf16* zp = PROJ + (size_t)(t0 + 16 * qd) * NPROJ + 2048 + h * 128 + k;
        float G[16], kk[16], vv[16];
        float run = 0.f;
#pragma unroll
        for (int i = 0; i < 16; ++i) {
            const float z = bf2f(zp[(size_t)i * NPROJ]); const float iv = bf2f(zp[(size_t)i * NPROJ + 512]);
            const float sg = sigmoidf_(z); const float f = lb + (1.f - lb) * sg;
            run += __logf(f); G[i] = run; kk[i] = 1.f - f; vv[i] = iv * sigmoidf_(iv);
        }
        part[qd * 128 + k] = run;
        __syncthreads();
        float off = 0.f, tot = 0.f;
#pragma unroll
        for (int q = 0; q < 4; ++q) { const float pv = part[q * 128 + k]; tot += pv; if (q < qd) off += pv; }
        {
            unsigned kw[8], vw[8];
#pragma unroll
            for (int i = 0; i < 8; ++i) {
                const float g0 = G[2 * i] + off, g1 = G[2 * i + 1] + off;
                kw[i] = pk2(kk[2 * i] * __expf(tot - g0), kk[2 * i + 1] * __expf(tot - g1));
                vw[i] = pk2(vv[2 * i], vv[2 * i + 1]);
            }
            u32x4* kd = (u32x4*)(KgT + k * 72 + 16 * qd); u32x4* vd = (u32x4*)(VT + k * 72 + 16 * qd);
            kd[0] = (u32x4){kw[0], kw[1], kw[2], kw[3]}; kd[1] = (u32x4){kw[4], kw[5], kw[6], kw[7]};
            vd[0] = (u32x4){vw[0], vw[1], vw[2], vw[3]}; vd[1] = (u32x4){vw[4], vw[5], vw[6], vw[7]};
        }
        if (qd == 0) DEC[item * 128 + k] = __expf(tot);
        __syncthreads();
        {
            const int mt = wave;
            bf16x8 a[2];
#pragma unroll
            for (int ks = 0; ks < 2; ++ks) a[ks] = *(const bf16x8*)(KgT + (16 * mt + fr) * 72 + 32 * ks + 8 * fq);
            bf16* ub = UT + (size_t)item * 16384 + 16 * mt + 4 * fq;
#pragma unroll
            for (int nt = 0; nt < 8; ++nt) {
                f32x4 acc = {0.f, 0.f, 0.f, 0.f};
#pragma unroll
                for (int ks = 0; ks < 2; ++ks) { const bf16x8 bb = *(const bf16x8*)(VT + (16 * nt + fr) * 72 + 32 * ks + 8 * fq); acc = MFMA16(a[ks], bb, acc); }
                { u32x2 w; w.x = pk2(acc[0], acc[1]); w.y = pk2(acc[2], acc[3]); *(u32x2*)(ub + (size_t)(16 * nt + fr) * 128) = w; }
            }
        }
        __syncthreads();
    }
}

__device__ __forceinline__ void phase_hgrn_b(const Params& p) {
    const bf16* UT = (const bf16*)p.out; const float* DEC = (const float*)(p.ws + WS_DEC); bf16* SP = (bf16*)p.out + (size_t)T_TOK * 1024;
    for (int e4 = blockIdx.x * 512 + threadIdx.x; e4 < 32 * 4096; e4 += gridDim.x * 512) {
        const int bh = e4 >> 12, r = e4 & 4095, k4 = (r & 31) * 4;
        f32x4 S = {0.f, 0.f, 0.f, 0.f};
#pragma unroll 8
        for (int c = 0; c < 32; ++c) {
            const int item = bh * 32 + c;
            u32x2 w; w.x = pk2(S[0], S[1]); w.y = pk2(S[2], S[3]);
            *(u32x2*)(SP + (size_t)item * 16384 + r * 4) = w;
            const f32x4 d = *(const f32x4*)(DEC + item * 128 + k4); const u32x2 uw = __builtin_nontemporal_load((const u32x2*)(UT + (size_t)item * 16384 + r * 4)); const f32x4 u = {bflo(uw.x), bfhi(uw.x), bflo(uw.y), bfhi(uw.y)};
            S = d * S + u;
        }
    }
}

__device__ __forceinline__ void phase_hgrn_c(const Params& p, unsigned char* smem) {
    const bf16* PROJ = (const bf16*)(p.ws + WS_BIG); const bf16* SP = (const bf16*)p.out + (size_t)T_TOK * 1024; bf16* MIX = (bf16*)(p.ws + WS_MIX);
    bf16* Am = (bf16*)smem;
    bf16* Bm = Am + 64 * 136;
    bf16* Qg = Bm + 64 * 136;
    bf16* VT = Qg + 64 * 136;
    bf16* P = VT + 128 * 72;
    float* part = (float*)(smem + 3 * 17408 + 18432 + 9216);
    float* rowss = part + 512;
    const int tid = threadIdx.x, lane = tid & 63, wave = tid >> 6, fr = lane & 15, fq = lane >> 4;
    const int k = tid & 127, qd = tid >> 7;
    typedef unsigned short us2 __attribute__((ext_vector_type(2)));
    us2 zi[16], qq[8];
    if ((int)blockIdx.x < 1024) {
        const int item = blockIdx.x; const int bh = item >> 5, c = item & 31, b = bh >> 2, h = bh & 3;
        const bf16* zp = PROJ + (size_t)(b * SEQ + c * 64 + 16 * qd) * NPROJ + 2048 + h * 128 + k;
#pragma unroll
        for (int i = 0; i < 16; ++i) { zi[i].x = zp[(size_t)i * NPROJ]; zi[i].y = zp[(size_t)i * NPROJ + 512]; if (i & 1) qq[i >> 1].y = zp[(size_t)i * NPROJ - 512]; else qq[i >> 1].x = zp[(size_t)i * NPROJ - 512]; }
    }
    for (int item = blockIdx.x; item < 1024; item += gridDim.x) {
        const int bh = item >> 5, c = item & 31, b = bh >> 2, h = bh & 3;
        const int t0 = b * SEQ + c * 64;
        const float lb = hgrn_lb_of(p, h * 128 + k);
        float G[16], kk[16], vv[16], qv[16];
        float run = 0.f;
#pragma unroll
        for (int i = 0; i < 16; ++i) {
            const float z = bf2f(zi[i].x); const float iv = bf2f(zi[i].y); qv[i] = bf2f((i & 1) ? qq[i >> 1].y : qq[i >> 1].x);
            const float sg = sigmoidf_(z); const float f = lb + (1.f - lb) * sg;
            run += __logf(f); G[i] = run; kk[i] = 1.f - f; vv[i] = iv * sigmoidf_(iv);
        }
        part[qd * 128 + k] = run;
#pragma unroll
        for (int i = 0; i < 16; ++i) {
            const int t = 16 * qd + i;
            Am[t * 136 + k] = (bf16)f2bf(qv[i] * __expf(G[i])); Bm[t * 136 + k] = (bf16)f2bf(kk[i] * __expf(run - G[i]));
        }
        for (int i = tid; i < 2304; i += 512) ((unsigned*)P)[i] = 0u;
        __syncthreads();
        float off = 0.f;
#pragma unroll
        for (int q = 0; q < 4; ++q) { const float pv = part[q * 128 + k]; if (q < qd) off += pv; }
        {
            unsigned vw[8];
#pragma unroll
            for (int i = 0; i < 16; ++i) {
                const float g = G[i] + off; const int t = 16 * qd + i;
                Qg[t * 136 + k] = (bf16)f2bf(qv[i] * __expf(g));
            }
#pragma unroll
            for (int i = 0; i < 8; ++i) vw[i] = pk2(vv[2 * i], vv[2 * i + 1]);
            u32x4* vd = (u32x4*)(VT + k * 72 + 16 * qd);
            vd[0] = (u32x4){vw[0], vw[1], vw[2], vw[3]}; vd[1] = (u32x4){vw[4], vw[5], vw[6], vw[7]};
        }
        __syncthreads();
        {
            const int nitem = item + gridDim.x;
            if (nitem < 1024) {
                const int nbh = nitem >> 5, nc = nitem & 31, nb = nbh >> 2, nh = nbh & 3;
                const bf16* zp = PROJ + (size_t)(nb * SEQ + nc * 64 + 16 * qd) * NPROJ + 2048 + nh * 128 + k;
#pragma unroll
                for (int i = 0; i < 16; ++i) { zi[i].x = zp[(size_t)i * NPROJ]; zi[i].y = zp[(size_t)i * NPROJ + 512]; if (i & 1) qq[i >> 1].y = zp[(size_t)i * NPROJ - 512]; else qq[i >> 1].x = zp[(size_t)i * NPROJ - 512]; }
            }
        }
        const int tt = wave & 3, vh = wave >> 2;
        bf16x8 sbf[4][4]; unsigned short gg[4][4];
        {
            const bf16* spb = SP + (size_t)item * 16384;
#pragma unroll
            for (int nt = 0; nt < 4; ++nt) {
                const int v = 16 * (4 * vh + nt) + fr;
#pragma unroll
                for (int ks = 0; ks < 4; ++ks) sbf[nt][ks] = __builtin_nontemporal_load((const bf16x8*)(spb + (size_t)v * 128 + 32 * ks + 8 * fq));
#pragma unroll
                for (int j = 0; j < 4; ++j) gg[nt][j] = PROJ[(size_t)(t0 + 16 * tt + 4 * fq + j) * NPROJ + 3072 + h * 128 + v];
            }
        }
        for (int sb = wave; sb < 10; sb += 8) {
            const int I = (sb >= 6) ? 3 : (sb >= 3) ? 2 : (sb >= 1) ? 1 : 0; const int J = sb - (I * (I + 1)) / 2;
            f32x4 acc = {0.f, 0.f, 0.f, 0.f};
#pragma unroll
            for (int ks = 0; ks < 4; ++ks) {
                const int kb = 32 * ks + 8 * fq;
                const bf16x8 av = *(const bf16x8*)(Am + (16 * I + fr) * 136 + kb);
                u32x4 bw = *(const u32x4*)(Bm + (16 * J + fr) * 136 + kb);
                if (J != I - 1) {
                    f32x4 e0, e1;
                    if (J == I) { e0 = -*(const f32x4*)(part + I * 128 + kb); e1 = -*(const f32x4*)(part + I * 128 + kb + 4); }
                    else {
                        e0 = *(const f32x4*)(part + (J + 1) * 128 + kb); e1 = *(const f32x4*)(part + (J + 1) * 128 + kb + 4);
                        if (I - J == 3) { e0 += *(const f32x4*)(part + (J + 2) * 128 + kb); e1 += *(const f32x4*)(part + (J + 2) * 128 + kb + 4); }
                    }
#pragma unroll
                    for (int e = 0; e < 4; ++e) {
                        const float xl = (e < 2) ? e0[2 * e] : e1[2 * e - 4], xh = (e < 2) ? e0[2 * e + 1] : e1[2 * e - 3];
                        bw[e] = pk2(bflo(bw[e]) * __expf(fminf(xl, 80.f)), bfhi(bw[e]) * __expf(fminf(xh, 80.f)));
                    }
                }
                acc = MFMA16(av, __builtin_bit_cast(bf16x8, bw), acc);
            }
#pragma unroll
            for (int j = 0; j < 4; ++j) { const int t = 16 * I + 4 * fq + j, s = 16 * J + fr; P[t * 72 + s] = (bf16)f2bf((s <= t) ? acc[j] : 0.f); }
        }
        __syncthreads();
        f32x4 o[4];
        {
            bf16x8 aq[4], ap[2];
#pragma unroll
            for (int ks = 0; ks < 4; ++ks) aq[ks] = *(const bf16x8*)(Qg + (16 * tt + fr) * 136 + 32 * ks + 8 * fq);
#pragma unroll
            for (int ks = 0; ks < 2; ++ks) ap[ks] = *(const bf16x8*)(P + (16 * tt + fr) * 72 + 32 * ks + 8 * fq);
#pragma unroll
            for (int nt = 0; nt < 4; ++nt) {
                const int v = 16 * (4 * vh + nt) + fr;
                f32x4 acc = {0.f, 0.f, 0.f, 0.f};
#pragma unroll
                for (int ks = 0; ks < 4; ++ks) acc = MFMA16(aq[ks], sbf[nt][ks], acc);
#pragma unroll
                for (int ks = 0; ks < 2; ++ks) { const bf16x8 bb = *(const bf16x8*)(VT + v * 72 + 32 * ks + 8 * fq); acc = MFMA16(ap[ks], bb, acc); }
                o[nt] = acc;
            }
        }
        {
            float s4[4];
#pragma unroll
            for (int j = 0; j < 4; ++j) {
                float s = o[0][j] * o[0][j] + o[1][j] * o[1][j] + o[2][j] * o[2][j] + o[3][j] * o[3][j];
                s += __shfl_xor(s, 1); s += __shfl_xor(s, 2); s += __shfl_xor(s, 4); s += __shfl_xor(s, 8);
                s4[j] = s;
            }
            if (fr == 0) {
#pragma unroll
                for (int j = 0; j < 4; ++j) rowss[(16 * tt + 4 * fq + j) * 2 + vh] = s4[j];
            }
        }
        __syncthreads();
#pragma unroll
        for (int j = 0; j < 4; ++j) {
            const int t = 16 * tt + 4 * fq + j;
            const float rs = rsqrtf((rowss[t * 2] + rowss[t * 2 + 1]) * (1.f / 128.f) + RMS_EPS);
#pragma unroll
            for (int nt = 0; nt < 4; ++nt) {
                const int v = 16 * (4 * vh + nt) + fr;
                const float g = bf2f(gg[nt][j]);
                const float val = o[nt][j] * rs * p.hgrn_norm[v] * (g * sigmoidf_(g));
                MIX[(size_t)(t0 + t) * 1024 + 512 + h * 128 + v] = (bf16)f2bf(val);
            }
        }
        __syncthreads();
    }
}

__device__ __forceinline__ int crow(int reg, int hi) { return (reg & 3) + 8 * (reg >> 2) + 4 * hi; }
constexpr float LOG2E = 1.4426950408889634f;

typedef short v4i16_t __attribute__((ext_vector_type(4)));
__device__ __forceinline__ u32x2 vtr_read(const unsigned char* pl) {
    return __builtin_bit_cast(u32x2, __builtin_amdgcn_ds_read_tr16_b64_v4i16((PG8_LAS v4i16_t*)pl));
}

#define ATT3_ISSUE_LOADS(BH, D, R, N) do { _Pragma("unroll") for (int i = 0; i < 8; ++i) { \
        const int chunk = i * 256 + gt, row = chunk >> 3, ch = chunk & 7; \
        const int kidx = 128 * ((N) - 1) + row; \
        kv[i] = (u32x4){0u, 0u, 0u, 0u}; vv[i] = (u32x4){0u, 0u, 0u, 0u}; \
        if (kidx >= 0) { const size_t off = ((size_t)(BH) * 2048 + kidx * (D) + (R)) * 64 + ch * 8; kv[i] = *(const u32x4*)(K + off); vv[i] = *(const u32x4*)(V + off); } } } while (0)
__device__ __forceinline__ void att3_job(int gp, int grp, int& bh, int& br, int& d, int& r, int& n) {
    bh = gp / 24; const int job = 2 * (gp - bh * 24) + grp;
    if (job < 16) { br = 0; d = 1; r = 0; n = job; }
    else if (job < 32) { br = 1; d = 4; r = (job - 16) >> 2; n = (job - 16) & 3; }
    else { br = 2; d = 16; r = job - 32; n = 0; }
}
template <int FIRST> __device__ __forceinline__ void att3_tiles(const unsigned char* kbase, const unsigned char* vbase, const bf16x8 (&qf)[4], int c, int hi,
                                                                float& mrun, float& lsum, f32x16& o0, f32x16& o1) {
    f32x16 scn;
#pragma unroll
    for (int j = 0; j < 16; ++j) scn[j] = 0.f;
    {
        const unsigned char* kp = kbase + (32 * FIRST) * 144;
#pragma unroll
        for (int ks = 0; ks < 4; ++ks) { const bf16x8 kf = *(const bf16x8*)(kp + 32 * ks); scn = MFMA32(kf, qf[ks], scn); }
    }
#pragma unroll
    for (int i = FIRST; i < 5; ++i) {
        f32x16 sc = scn;
        if (i + 1 < 5) {
#pragma unroll
            for (int j = 0; j < 16; ++j) scn[j] = 0.f;
            const unsigned char* kp = kbase + (32 * (i + 1)) * 144;
#pragma unroll
            for (int ks = 0; ks < 4; ++ks) { const bf16x8 kf = *(const bf16x8*)(kp + 32 * ks); scn = MFMA32(kf, qf[ks], scn); }
        }
        if (i == 0) {
#pragma unroll
            for (int j = 0; j < 16; ++j) sc[j] = (crow(j, hi) >= c) ? sc[j] : -1e30f;
        }
        if (i == 4) {
#pragma unroll
            for (int j = 0; j < 16; ++j) sc[j] = (crow(j, hi) <= c) ? sc[j] : -1e30f;
        }
        float mx = sc[0];
#pragma unroll
        for (int j = 1; j < 16; ++j) mx = fmaxf(mx, sc[j]);
        mx = xor32_max(mx);
        const float mnew = fmaxf(mrun, mx);
        const float alpha = __builtin_amdgcn_exp2f((mrun - mnew) * LOG2E);
        const float mL = mnew * LOG2E;
        float rs = 0.f;
#pragma unroll
        for (int j = 0; j < 16; ++j) { const float pj = __builtin_amdgcn_exp2f(sc[j] * LOG2E - mL); sc[j] = pj; rs += pj; }
        rs = xor32_sum(rs);
        lsum = lsum * alpha + rs; mrun = mnew;
#pragma unroll
        for (int j = 0; j < 16; ++j) { o0[j] *= alpha; o1[j] *= alpha; }
        const unsigned char* vp = vbase + (32 * i) * 144;
#pragma unroll
        for (int ks = 0; ks < 2; ++ks) {
            u32x4 w; w.x = pk2(sc[8 * ks], sc[8 * ks + 1]); w.y = pk2(sc[8 * ks + 2], sc[8 * ks + 3]);
            w.z = pk2(sc[8 * ks + 4], sc[8 * ks + 5]); w.w = pk2(sc[8 * ks + 6], sc[8 * ks + 7]);
            const bf16x8 pb = __builtin_bit_cast(bf16x8, w);
            const u32x2 a00 = vtr_read(vp + (16 * ks) * 144), a01 = vtr_read(vp + (16 * ks + 8) * 144);
            const u32x2 a10 = vtr_read(vp + (16 * ks) * 144 + 64), a11 = vtr_read(vp + (16 * ks + 8) * 144 + 64);
            const u32x4 A0 = {a00.x, a00.y, a01.x, a01.y}, A1 = {a10.x, a10.y, a11.x, a11.y};
            o0 = MFMA32(__builtin_bit_cast(bf16x8, A0), pb, o0);
            o1 = MFMA32(__builtin_bit_cast(bf16x8, A1), pb, o1);
        }
    }
}
__device__ __forceinline__ void phase_attn3(const Params& p, unsigned char* smem) {
    const bf16* Q = (const bf16*)(p.ws + WS_BIG); const bf16* K = Q + (size_t)T_TOK * 1024; const bf16* V = K + (size_t)T_TOK * 1024;
    float* LSE = (float*)(p.ws + WS_LSE);
    const int tid = threadIdx.x, lane = tid & 63, wave = tid >> 6, c = lane & 31, hi = lane >> 5;
    const int grp = wave >> 2, w4 = wave & 3, gt = tid & 255;
    unsigned char* Kl = smem + grp * 73728; unsigned char* Vl = Kl + 36864;
    const int trl = 144 * ((lane & 15) >> 2) + 32 * ((lane >> 4) & 1) + 8 * (lane & 3) + 144 * 4 * hi;
    const int G = gridDim.x; const bool xcdmap = (G == 256);
    const int xcd = blockIdx.x & 7, li = blockIdx.x >> 3;
    const int cnt = xcdmap ? 12 : ((3072 - (int)blockIdx.x + G - 1) / G);
#define ATT3_GP(i) (xcdmap ? (xcd * 384 + li + 32 * (i)) : ((int)blockIdx.x + G * (i)))
    if (cnt <= 0) return;
    u32x4 kv[8], vv[8];
    int bh, br, d, r, n;
    att3_job(ATT3_GP(0), grp, bh, br, d, r, n);
    ATT3_ISSUE_LOADS(bh, d, r, n);
    for (int it = 0; it < cnt; ++it) {
        const int qi0 = 128 * n + 32 * w4, rowoff = 128 - 128 * n;
#pragma unroll
        for (int i = 0; i < 8; ++i) {
            const int chunk = i * 256 + gt, row = chunk >> 3, ch = chunk & 7;
            *(u32x4*)(Kl + row * 144 + ch * 16) = kv[i]; *(u32x4*)(Vl + row * 144 + ch * 16) = vv[i];
        }
        const int b = bh >> 4, h = bh & 15;
        const int tok = b * SEQ + (qi0 + c) * d + r;
        bf16x8 qf[4];
        {
            const bf16* qp = Q + ((size_t)bh * 2048 + (qi0 + c) * d + r) * 64 + 8 * hi;
#pragma unroll
            for (int ks = 0; ks < 4; ++ks) qf[ks] = *(const bf16x8*)(qp + 16 * ks);
        }
        const int cbr = br;
        __syncthreads();
        if (it + 1 < cnt) { att3_job(ATT3_GP(it + 1), grp, bh, br, d, r, n); ATT3_ISSUE_LOADS(bh, d, r, n); }
        float mrun = -1e30f, lsum = 0.f;
        f32x16 o0, o1;
#pragma unroll
        for (int j = 0; j < 16; ++j) { o0[j] = 0.f; o1[j] = 0.f; }
        {
            const int first = (qi0 >= 128) ? 0 : (4 - (qi0 >> 5));
            const unsigned char* kbase = Kl + (rowoff + qi0 - 128 + c) * 144 + 16 * hi;
            const unsigned char* vbase = Vl + (rowoff + qi0 - 128) * 144 + trl;
            switch (first) {
            case 0: att3_tiles<0>(kbase, vbase, qf, c, hi, mrun, lsum, o0, o1); break;
            case 1: att3_tiles<1>(kbase, vbase, qf, c, hi, mrun, lsum, o0, o1); break;
            case 2: att3_tiles<2>(kbase, vbase, qf, c, hi, mrun, lsum, o0, o1); break;
            case 3: att3_tiles<3>(kbase, vbase, qf, c, hi, mrun, lsum, o0, o1); break;
            default: att3_tiles<4>(kbase, vbase, qf, c, hi, mrun, lsum, o0, o1); break;
            }
        }
        {
            bf16* OB = (cbr == 2) ? (bf16*)(p.ws + WS_OB2) : ((bf16*)p.out + (size_t)cbr * ((size_t)T_TOK * 1024));
            const float inv = __builtin_amdgcn_rcpf(lsum);
            bf16* op = OB + (size_t)tok * 1024 + h * 64 + 4 * hi;
#pragma unroll
            for (int q = 0; q < 4; ++q) {
                u32x2 w0, w1;
                w0.x = pg8::cvt_pk_bf16(o0[4 * q] * inv, o0[4 * q + 1] * inv); w0.y = pg8::cvt_pk_bf16(o0[4 * q + 2] * inv, o0[4 * q + 3] * inv);
                w1.x = pg8::cvt_pk_bf16(o1[4 * q] * inv, o1[4 * q + 1] * inv); w1.y = pg8::cvt_pk_bf16(o1[4 * q + 2] * inv, o1[4 * q + 3] * inv);
                *(u32x2*)(op + 8 * q) = w0; *(u32x2*)(op + 32 + 8 * q) = w1;
            }
            if (hi == 0) LSE[(size_t)cbr * (T_TOK * 16) + (size_t)tok * 16 + h] = mrun * LOG2E + __builtin_amdgcn_logf(lsum);
        }
        __syncthreads();
    }
}
__device__ __forceinline__ void phase_attn_merge(const Params& p) {
    const bf16* O0 = (const bf16*)p.out; const bf16* O1 = O0 + (size_t)T_TOK * 1024; const bf16* O2 = (const bf16*)(p.ws + WS_OB2);
    const float* LSE = (const float*)(p.ws + WS_LSE); bf16* ATT = (bf16*)(p.ws + WS_MIX);
    const bool xcdmap = (gridDim.x == 256);
    const int total = T_TOK * 128;
    const int nthr = xcdmap ? 32 * 512 : (int)gridDim.x * 512;
    const int first = xcdmap ? ((int)(blockIdx.x >> 3) * 512 + (int)threadIdx.x) : ((int)blockIdx.x * 512 + (int)threadIdx.x);
    const int base = xcdmap ? (int)(blockIdx.x & 7) * (SEQ * 128) : 0;
    const int lim = xcdmap ? SEQ * 128 : total;
    for (int j = first; j < lim; j += nthr) {
        const int i = base + j;
        const int tok = i >> 7, c8 = (i & 127) * 8, h = c8 >> 6;
        const float l0 = LSE[(size_t)tok * 16 + h], l1 = LSE[(size_t)T_TOK * 16 + (size_t)tok * 16 + h], l2 = LSE[(size_t)2 * T_TOK * 16 + (size_t)tok * 16 + h];
        const float M = fmaxf(l0, fmaxf(l1, l2));
        const float e0 = __builtin_amdgcn_exp2f(l0 - M), e1 = __builtin_amdgcn_exp2f(l1 - M), e2 = __builtin_amdgcn_exp2f(l2 - M);
        const float isum = __builtin_amdgcn_rcpf(e0 + e1 + e2); const float w0 = e0 * isum, w1 = e1 * isum, w2 = e2 * isum;
        const size_t off = (size_t)tok * 1024 + c8;
        const u32x4 a = __builtin_nontemporal_load((const u32x4*)(O0 + off)), bq = __builtin_nontemporal_load((const u32x4*)(O1 + off)), cc = __builtin_nontemporal_load((const u32x4*)(O2 + off));
        u32x4 o;
#pragma unroll
        for (int q = 0; q < 4; ++q) o[q] = pk2(bflo(a[q]) * w0 + bflo(bq[q]) * w1 + bflo(cc[q]) * w2, bfhi(a[q]) * w0 + bfhi(bq[q]) * w1 + bfhi(cc[q]) * w2);
        *(u32x4*)(ATT + off) = o;
    }
}

__device__ __forceinline__ void phase_final(const Params& p) {
    const float* ss = (const float*)(p.ws + WS_SS) + 4 * T_TOK; const bf16* XB = (const bf16*)(p.ws + WS_XB);
    for (int i = blockIdx.x * 512 + threadIdx.x; i < T_TOK * 128; i += gridDim.x * 512) {
        const int row = i >> 7, c8 = (i & 127) * 8;
        const float r = rsqrtf(ss[row] * (1.f / 1024.f) + RMS_EPS);
        const u32x4 xv = __builtin_nontemporal_load((const u32x4*)(XB + (size_t)row * 1024 + c8));
        const f32x4 g0 = *(const f32x4*)(p.final_norm + c8), g1 = *(const f32x4*)(p.final_norm + c8 + 4);
        f32x4 o0 = {bflo(xv.x), bfhi(xv.x), bflo(xv.y), bfhi(xv.y)}, o1 = {bflo(xv.z), bfhi(xv.z), bflo(xv.w), bfhi(xv.w)};
        *(f32x4*)(p.out + (size_t)row * 1024 + c8) = o0 * r * g0; *(f32x4*)(p.out + (size_t)row * 1024 + c8 + 4) = o1 * r * g1;
    }
}

#define XB_TMO      128
#define XB_XCNT(j)  (256  + 64 * (j))
#define XB_XSUB(j)  (1280 + 64 * (j))
#define XB_XGEN(j)  (2304 + 64 * (j))
#define XB_TOP      3328
#define XB_TOPGEN   3392
#define XCD_BAR_WORDS 3456
#define XB_SPIN_CAP (1u << 18)

__device__ __forceinline__ unsigned xb_ld(unsigned* p)              { return __hip_atomic_load(p, __ATOMIC_RELAXED, __HIP_MEMORY_SCOPE_AGENT); }
__device__ __forceinline__ unsigned xb_add(unsigned* p, unsigned v) { return __hip_atomic_fetch_add(p, v, __ATOMIC_RELAXED, __HIP_MEMORY_SCOPE_AGENT); }
__device__ __forceinline__ unsigned xb_xcc_id() { return (unsigned)__builtin_amdgcn_s_getreg((3 << 11) | 20) & 0xFu; }
#define XB_SPIN(cond, bar) do { unsigned _sp = 0; while (cond) { __builtin_amdgcn_s_sleep(1); \
    if ((++_sp & 255u) == 0u) { if (xb_ld(&(bar)[XB_TMO])) break; if (_sp > XB_SPIN_CAP) { atomicAdd(&(bar)[XB_TMO], 1u); break; } } } } while (0)

struct XcdBarrier {
    unsigned* bar; unsigned x;
    volatile PG8_LAS unsigned* st;
};

__device__ __forceinline__ XcdBarrier xcd_barrier_post(unsigned* bar, volatile PG8_LAS unsigned* st) {
    XcdBarrier b; b.bar = bar; b.x = xb_xcc_id(); b.st = st;
    if (threadIdx.x == 0) (void)xb_add(&bar[XB_XCNT(b.x)], 1u);
    return b;
}
__device__ __forceinline__ void xcd_barrier_complete(unsigned* bar, unsigned x, unsigned& nloc, unsigned& nx) {
    const unsigned G = gridDim.x * gridDim.y * gridDim.z;
    unsigned sum, cnt, mine, sp = 0u;
    for (;;) {
        sum = 0u; cnt = 0u; mine = 0u;
#pragma unroll
        for (unsigned j = 0; j < 16; ++j) { const unsigned c = xb_ld(&bar[XB_XCNT(j)]); sum += c; cnt += (c > 0u) ? 1u : 0u; mine = (j == x) ? c : mine; }
        if (sum == G) break;
        __builtin_amdgcn_s_sleep(1);
        if ((++sp & 255u) == 0u) { if (xb_ld(&bar[XB_TMO])) break; if (sp > XB_SPIN_CAP) { atomicAdd(&bar[XB_TMO], 1u); break; } }
    }
    nloc = mine > 0u ? mine : 1u; nx = cnt > 0u ? cnt : 1u;
}

__device__ __forceinline__ void xcd_barrier(const XcdBarrier& b) {
    asm volatile("s_waitcnt vmcnt(0)" ::: "memory");
    __syncthreads();
    if (threadIdx.x == 0) {
        unsigned* bar = b.bar;
        __builtin_amdgcn_s_waitcnt(0);
        unsigned nloc = b.st[0], nx = b.st[1];
        if (nloc == 0u) { xcd_barrier_complete(bar, b.x, nloc, nx); b.st[0] = nloc; b.st[1] = nx; }
        const unsigned old = xb_add(&bar[XB_XSUB(b.x)], 1u);
        const unsigned gen = old / nloc;
        if (old + 1u == (gen + 1u) * nloc) {
            __builtin_amdgcn_fence(__ATOMIC_RELEASE, "agent");
            asm volatile("s_waitcnt vmcnt(0)" ::: "memory");
            const unsigned og = xb_add(&bar[XB_TOP], 1u);
            const unsigned tg = og / nx;
            if (og + 1u == (tg + 1u) * nx) xb_add(&bar[XB_TOPGEN], 1u);
            else XB_SPIN(xb_ld(&bar[XB_TOPGEN]) == tg, bar);
            __builtin_amdgcn_fence(__ATOMIC_ACQUIRE, "agent");
            xb_add(&bar[XB_XGEN(b.x)], 1u);
            asm volatile("s_waitcnt vmcnt(0)" ::: "memory");
        } else {
            XB_SPIN(xb_ld(&bar[XB_XGEN(b.x)]) == gen, bar);
            __builtin_amdgcn_fence(__ATOMIC_ACQUIRE, "agent");
            asm volatile("s_waitcnt vmcnt(0)" ::: "memory");
        }
    }
    __syncthreads();
}


constexpr int N_PHASES = 15;
#ifndef MK_CGSYNC
#define MK_CGSYNC 0
#endif
#ifndef PH_EN
#define PH_EN 0xfffff
#endif
#define EN(n) ((PH_EN >> (n)) & 1)
#ifndef REP_MASK
#define REP_MASK 0
#endif
#define REPS(n) (1 + ((REP_MASK >> (n)) & 1))
__global__ void __launch_bounds__(512, 2) mk_fwd(Params p, int ph_lo, int ph_hi) {
    extern __shared__ __attribute__((aligned(16))) unsigned char smem[];
    cg::grid_group grid = cg::this_grid();
    volatile PG8_LAS unsigned* xst = (volatile PG8_LAS unsigned*)((PG8_LAS unsigned char*)smem + LDS_MISC);
    if (threadIdx.x < 2) xst[threadIdx.x] = 0u;
    __syncthreads();
    XcdBarrier xbar = xcd_barrier_post((unsigned*)(p.ws + WS_BAR), xst);
#define IN(k) (EN(k) && ph_lo <= (k) && (k) < ph_hi)
#define SEAM(k) do { if ((k) + 1 < ph_hi) { if (MK_CGSYNC) grid.sync(); else xcd_barrier(xbar); } } while (0)
#define LDSP ((PG8_LAS unsigned char*)smem)
#define SSB ((float*)(p.ws + WS_SS))
#define WSB(off) ((bf16*)(p.ws + (off)))
    if (ph_hi > 1000) grid.sync();
    if (IN(0)) { for (int rep = 0; rep < REPS(0); ++rep) phase_prologue(p, smem); SEAM(0); }
    if (IN(1)) for (int rep = 0; rep < REPS(1); ++rep) {
        pg8::Gemm g{WSB(WS_XB), WSB(WS_W_INREC), T_TOK, NPROJ, DM}; pg8::StaticOrder S; S.init(T_TOK, NPROJ, gridDim.x, blockIdx.x);
        pg8::EpiScaleBf16 E{WSB(WS_BIG), NPROJ, SSB};
        pg8::gemm_phase<pg8::EpiScaleBf16, pg8::StaticOrder, true, true>(LDSP, g, S, E);
        {
            const int G = gridDim.x, rem = (64 * 14) % G;
            if (rem == 0) convert_items(p, smem, CONV_SPLIT, CONV_SPLIT2, blockIdx.x, G);
            else if ((int)blockIdx.x >= rem) convert_items(p, smem, CONV_SPLIT, CONV_SPLIT2, blockIdx.x - rem, G - rem);
        }
        SEAM(1);
    }
    if (IN(2)) { for (int rep = 0; rep < REPS(2); ++rep) { phase_conv(p); phase_hgrn_a(p, smem); } SEAM(2); }
    if (IN(3)) { for (int rep = 0; rep < REPS(3); ++rep) phase_hgrn_b(p); SEAM(3); }
    if (IN(4)) { for (int rep = 0; rep < REPS(4); ++rep) phase_hgrn_c(p, smem); SEAM(4); }
    if (IN(5)) {
        pg8::Gemm g{WSB(WS_MIX), WSB(WS_W_OUTREC), T_TOK, DM, DM}; pg8::StaticOrder S; S.init(T_TOK, DM, gridDim.x, blockIdx.x);
        pg8::EpiResid E{nullptr, WSB(WS_XB), WSB(WS_XB), SSB + 1 * T_TOK};
        pg8::gemm_phase<pg8::EpiResid, pg8::StaticOrder, true, true>(LDSP, g, S, E);
        SEAM(5);
    }
    if (IN(6)) for (int rep = 0; rep < REPS(6); ++rep) {
        pg8::Gemm g{WSB(WS_XB), WSB(WS_W_FFNIN0), T_TOK, 2 * DFF, DM}; pg8::StaticOrder S; S.init(T_TOK, 2 * DFF, gridDim.x, blockIdx.x);
        pg8::EpiSwiGLU E{WSB(WS_BIG), SSB + 1 * T_TOK};
        pg8::gemm_phase<pg8::EpiSwiGLU, pg8::StaticOrder, true, true>(LDSP, g, S, E);
        {
            const int G = gridDim.x, rem = (64 * 22) % G;
            if (rem == 0) convert_items(p, smem, CONV_SPLIT2, 1600, blockIdx.x, G);
            else if ((int)blockIdx.x >= rem) convert_items(p, smem, CONV_SPLIT2, 1600, blockIdx.x - rem, G - rem);
        }
        SEAM(6);
    }
    if (IN(7)) {
        pg8::Gemm g{WSB(WS_BIG), WSB(WS_W_FFNOUT0), T_TOK, DM, DFF}; pg8::StaticOrder S; S.init(T_TOK, DM, gridDim.x, blockIdx.x);
        pg8::EpiResid E{nullptr, WSB(WS_XB), WSB(WS_XB), SSB + 2 * T_TOK};
        pg8::gemm_phase<pg8::EpiResid, pg8::StaticOrder, true, true>(LDSP, g, S, E);
        SEAM(7);
    }
    if (IN(8)) {
        pg8::Gemm g{WSB(WS_XB), WSB(WS_W_QKV), T_TOK, 3 * DM, DM}; pg8::StaticOrder S; S.init(T_TOK, 3 * DM, gridDim.x, blockIdx.x);
        pg8::EpiQKV E{WSB(WS_BIG), SSB + 2 * T_TOK, (const float*)(p.ws + WS_ROPE)};
        pg8::gemm_phase<pg8::EpiQKV, pg8::StaticOrder, true, true>(LDSP, g, S, E);
        SEAM(8);
    }
    if (IN(9)) { for (int rep = 0; rep < REPS(9); ++rep) phase_attn3(p, smem); SEAM(9); }
    if (IN(10)) { phase_attn_merge(p); SEAM(10); }
    if (IN(11)) {
        pg8::Gemm g{WSB(WS_MIX), WSB(WS_W_O), T_TOK, DM, DM}; pg8::StaticOrder S; S.init(T_TOK, DM, gridDim.x, blockIdx.x);
        pg8::EpiResid E{nullptr, WSB(WS_XB), WSB(WS_XB), SSB + 3 * T_TOK};
        pg8::gemm_phase<pg8::EpiResid, pg8::StaticOrder, true, true>(LDSP, g, S, E);
        SEAM(11);
    }
    if (IN(12)) {
        pg8::Gemm g{WSB(WS_XB), WSB(WS_W_FFNIN1), T_TOK, 2 * DFF, DM}; pg8::StaticOrder S; S.init(T_TOK, 2 * DFF, gridDim.x, blockIdx.x);
        pg8::EpiSwiGLU E{WSB(WS_BIG), SSB + 3 * T_TOK};
        pg8::gemm_phase<pg8::EpiSwiGLU, pg8::StaticOrder, true, true>(LDSP, g, S, E);
        SEAM(12);
    }
    if (IN(13)) {
        pg8::Gemm g{WSB(WS_BIG), WSB(WS_W_FFNOUT1), T_TOK, DM, DFF}; pg8::StaticOrder S; S.init(T_TOK, DM, gridDim.x, blockIdx.x);
        pg8::EpiResid E{nullptr, WSB(WS_XB), WSB(WS_XB), SSB + 4 * T_TOK};
        pg8::gemm_phase<pg8::EpiResid, pg8::StaticOrder, true, true>(LDSP, g, S, E);
        SEAM(13);
    }
    if (IN(14)) { phase_final(p); }
}

extern "C" void kernel_launch(void* const* d_in, const int* in_sizes, int n_in, void* d_out, int out_size, void* d_ws, size_t ws_size, hipStream_t stream) {
    static int grid = 0;
    if (grid == 0) {
        if (n_in != 13 || in_sizes[0] != T_TOK * DM || out_size != T_TOK * DM || ws_size < WS_END) {
            fprintf(stderr, "kernel_launch: unexpected shapes (n_in %d, in0 %d, out %d, ws %zu)\n", n_in, n_in > 0 ? in_sizes[0] : -1, out_size, ws_size); grid = -1; return;
        }
        int dev = 0, cus = 0, per_cu = 0;
        hipGetDevice(&dev); hipDeviceGetAttribute(&cus, hipDeviceAttributeMultiprocessorCount, dev);
        if (hipFuncSetAttribute((const void*)mk_fwd, hipFuncAttributeMaxDynamicSharedMemorySize, LDS_BYTES) != hipSuccess) { fprintf(stderr, "kernel_launch: hipFuncSetAttribute failed\n"); grid = -1; return; }
        if (hipOccupancyMaxActiveBlocksPerMultiprocessor(&per_cu, (const void*)mk_fwd, 512, LDS_BYTES) != hipSuccess || per_cu < 1) { fprintf(stderr, "kernel_launch: occupancy query says %d\n", per_cu); per_cu = 1; (void)hipGetLastError(); }
        grid = cus * 1;
        if (per_cu < 1) grid = -1;
    }
    if (grid < 0) return;
    Params p{};
    p.x = (const float*)d_in[0]; p.mix_norm = (const float*)d_in[1]; p.ffn_norm = (const float*)d_in[2]; p.w_in_rec = (const float*)d_in[3]; p.conv_w = (const float*)d_in[4];
    p.hgrn_lb = (const float*)d_in[5]; p.hgrn_norm = (const float*)d_in[6]; p.w_out_rec = (const float*)d_in[7]; p.w_qkv = (const float*)d_in[8]; p.w_o = (const float*)d_in[9];
    p.w_ffn_in = (const float*)d_in[10]; p.w_ffn_out = (const float*)d_in[11]; p.final_norm = (const float*)d_in[12];
    p.out = (float*)d_out; p.ws = (unsigned char*)d_ws;
    if (hipMemsetAsync((char*)d_ws + WS_BAR, 0, 16384, stream) != hipSuccess) { fprintf(stderr, "kernel_launch: memset failed\n"); return; }
#if MK_SPLIT
    for (int ph = 0; ph < N_PHASES; ++ph) {
        hipLaunchKernelGGL(mk_fwd, dim3(grid), dim3(512), LDS_BYTES, stream, p, ph, ph + 1);
    }
#else
    int lo = 0, hi = N_PHASES;
    void* args[] = {&p, &lo, &hi};
    hipError_t e = hipLaunchCooperativeKernel((const void*)mk_fwd, dim3(grid), dim3(512), args, LDS_BYTES, stream);
    if (e != hipSuccess) fprintf(stderr, "kernel_launch: cooperative launch failed: %s (grid %d)\n", hipGetErrorString(e), grid);
#endif
}
```
